# Optimizing an MI355X kernel written in HIP

```python
import jax, jax.numpy as jnp
from jax import lax
import numpy as np

D_MODEL = 2048
BATCH = 16
SEQ = 256
DEPTH = 2
DEC_BATCH = 4
DEC_SEQ = 4096
PAST_LEN = 512

GRID_W = 64
NA_HEADS = 8
NA_HEAD_DIM = 128
NA_WIN_ROWS = 8
NA_WIN_COLS = 16
RET_HEADS = 8
RET_DK = 128
RET_DV = 128
M_HEADS = 8
M_DK = 128
M_DV = 128
D_FF = 4 * D_MODEL
CHUNK = 128
Q_BLOCK = 128
ROPE_BASE = 10000.0
NORM_EPS = 1e-6
NA_W = NA_HEADS * NA_HEAD_DIM
RET_QK_W = RET_HEADS * RET_DK
RET_W = RET_HEADS * RET_DV
M_QK_W = M_HEADS * M_DK
M_W = M_HEADS * M_DV
N_GATES = 4 * M_HEADS
IN_WIDTHS = (NA_W, NA_W, NA_W, RET_QK_W, RET_QK_W, RET_W, RET_W, M_QK_W, M_QK_W, M_W, M_W, N_GATES, 3 * D_MODEL)
IN_SPLITS = tuple(int(s) for s in np.cumsum(IN_WIDTHS)[:-1])
N_IN = int(sum(IN_WIDTHS))

kernel_name = 'hybrid_na_retnet_mlstm_dit_step'


def rms_norm(x, g):
    xf = x.astype(jnp.float32)
    y = xf * lax.rsqrt(jnp.mean(xf * xf, axis=-1, keepdims=True) + NORM_EPS)
    return (y * g.astype(jnp.float32)).astype(x.dtype)


def _blocks(a, size):
    b, t = a.shape[:2]
    return a.reshape((b, t // size, size) + a.shape[2:]).swapaxes(0, 1)


def _unblocks(a):
    a = a.swapaxes(0, 1)
    return a.reshape((a.shape[0], a.shape[1] * a.shape[2]) + a.shape[3:])


def _flip(a):
    return a[:, ::-1]


def axial_rope(x):
    t = jnp.arange(x.shape[1])
    row = (t // GRID_W).astype(jnp.float32)
    col = (t % GRID_W).astype(jnp.float32)
    half = x.shape[-1] // 2
    quarter = half // 2
    inv_freq = ROPE_BASE ** (-jnp.arange(quarter, dtype=jnp.float32) / quarter)

    def rotate(xa, pos):
        ang = pos[:, None] * inv_freq[None, :]
        cos = jnp.cos(ang)[None, :, None, :]
        sin = jnp.sin(ang)[None, :, None, :]
        x1, x2 = xa[..., :quarter], xa[..., quarter:]
        return jnp.concatenate([x1 * cos - x2 * sin, x2 * cos + x1 * sin], axis=-1)

    return jnp.concatenate([rotate(x[..., :half], row), rotate(x[..., half:], col)], axis=-1).astype(x.dtype)


def context_attention(q, k, v):
    def block(qc):
        s = jnp.einsum('bqhd,bkhd->bhqk', qc, k).astype(jnp.float32)
        p = jax.nn.softmax(s, axis=-1).astype(v.dtype)
        return jnp.einsum('bhqk,bkhd->bqhd', p, v)
    return _unblocks(lax.map(block, _blocks(q, Q_BLOCK)))


def neighborhood_attention(q, k, v, ck, cv, rpb):
    b, t, h, d = q.shape
    rows = t // GRID_W
    kr = min(NA_WIN_ROWS, rows)
    kc = NA_WIN_COLS
    qg = q.reshape(b, rows, GRID_W, h, d)
    kg = k.reshape(b, rows, GRID_W, h, d)
    vg = v.reshape(b, rows, GRID_W, h, d)
    r = jnp.arange(rows)
    row_start = jnp.clip(r - kr // 2, 0, rows - kr)
    row_off = row_start[:, None] + jnp.arange(kr)[None] - r[:, None] + NA_WIN_ROWS - 1
    cidx = jnp.arange(GRID_W)
    col_start = jnp.clip(cidx - kc // 2, 0, GRID_W - kc)
    col_idx = col_start[:, None] + jnp.arange(kc)[None]
    col_off = col_idx - cidx[:, None] + NA_WIN_COLS - 1
    n_loc = kr * kc

    def row_block(args):
        qr, start, roff = args
        kwin = lax.dynamic_slice_in_dim(kg, start, kr, axis=1)
        vwin = lax.dynamic_slice_in_dim(vg, start, kr, axis=1)
        kn = kwin[:, :, col_idx]
        vn = vwin[:, :, col_idx]
        s_loc = jnp.einsum('bqhd,biqjhd->bhqij', qr, kn).astype(jnp.float32)
        bias = rpb[:, roff[:, None, None], col_off[None, :, :]]
        s_loc = s_loc + bias.transpose(0, 2, 1, 3)[None].astype(jnp.float32)
        s_ctx = jnp.einsum('bqhd,bkhd->bhqk', qr, ck).astype(jnp.float32)
        s_all = jnp.concatenate([s_loc.reshape(b, h, GRID_W, n_loc), s_ctx], axis=-1)
        p = jax.nn.softmax(s_all, axis=-1).astype(v.dtype)
        p_loc = p[..., :n_loc].reshape(b, h, GRID_W, kr, kc)
        p_ctx = p[..., n_loc:]
        return jnp.einsum('bhqij,biqjhd->bqhd', p_loc, vn) + jnp.einsum('bhqk,bkhd->bqhd', p_ctx, cv)

    out = lax.map(row_block, (qg.swapaxes(0, 1), row_start, row_off))
    return out.swapaxes(0, 1).reshape(b, t, h, d)


def retention_scan(q, k, v, log_gamma, s0):
    idx = jnp.arange(CHUNK, dtype=jnp.float32)
    diff = idx[:, None] - idx[None, :]
    decay = jnp.exp(jnp.where((diff >= 0)[None], diff[None] * log_gamma[:, None, None], -jnp.inf))
    inner = jnp.exp((idx[None] + 1.0) * log_gamma[:, None]).T[None, :, :, None]
    k_dec = jnp.exp((CHUNK - 1.0 - idx[None]) * log_gamma[:, None])
    chunk_dec = jnp.exp(CHUNK * log_gamma)[None, :, None, None]

    def step(s, inp):
        qc, kc, vc = inp
        scores = jnp.einsum('bihd,bjhd->bhij', qc, kc) * decay
        out = jnp.einsum('bhij,bjhe->bihe', scores, vc) + inner * jnp.einsum('bihd,bhde->bihe', qc, s)
        s = chunk_dec * s + jnp.einsum('bjhd,bjhe,hj->bhde', kc, vc, k_dec)
        return s, out

    s_fin, out = lax.scan(step, s0.astype(jnp.float32), (_blocks(q, CHUNK), _blocks(k, CHUNK), _blocks(v, CHUNK)))
    return _unblocks(out), s_fin


def mlstm_scan(q, k, v, i_pre, f_pre, c0, n0, m0):
    idx = jnp.arange(CHUNK)
    causal = idx[:, None] >= idx[None, :]

    def step(carry, inp):
        c, n, m = carry
        qc, kc, vc, ic, lfc = inp
        bcum = jnp.cumsum(lfc, axis=1).swapaxes(1, 2)
        ii = ic.swapaxes(1, 2)
        log_w = jnp.where(causal, bcum[..., :, None] - bcum[..., None, :] + ii[..., None, :], -jnp.inf)
        log_inter = bcum + m[..., None]
        m_t = jnp.maximum(log_inter, jnp.max(log_w, axis=-1))
        scores = jnp.einsum('bthd,bshd->bhts', qc, kc) * jnp.exp(log_w - m_t[..., None])
        w_inter = jnp.exp(log_inter - m_t).swapaxes(1, 2)[..., None]
        num = jnp.einsum('bhts,bshe->bthe', scores, vc) + w_inter * jnp.einsum('bthd,bhde->bthe', qc, c)
        den = jnp.sum(scores, axis=-1).swapaxes(1, 2) + w_inter[..., 0] * jnp.einsum('bthd,bhd->bth', qc, n)
        floor = jnp.exp(-m_t).swapaxes(1, 2)
        hc = num / jnp.maximum(jnp.abs(den), floor)[..., None]
        b_end = bcum[..., -1]
        log_kw = b_end[..., None] - bcum + ii
        m_new = jnp.maximum(b_end + m, jnp.max(log_kw, axis=-1))
        kw = jnp.exp(log_kw - m_new[..., None])
        carry_dec = jnp.exp(b_end + m - m_new)
        c_new = carry_dec[..., None, None] * c + jnp.einsum('bhs,bshd,bshe->bhde', kw, kc, vc)
        n_new = carry_dec[..., None] * n + jnp.einsum('bhs,bshd->bhd', kw, kc)
        return (c_new, n_new, m_new), hc

    log_f = jax.nn.log_sigmoid(f_pre)
    init = (c0.astype(jnp.float32), n0.astype(jnp.float32), m0.astype(jnp.float32))
    (c_f, n_f, m_f), h = lax.scan(step, init, (_blocks(q, CHUNK), _blocks(k, CHUNK), _blocks(v, CHUNK), _blocks(i_pre, CHUNK), _blocks(log_f, CHUNK)))
    return _unblocks(h), c_f, n_f, m_f


def token_mixers(h, lw, latent, ctx_k, ctx_v, ret_s0, mc0, mn0, mm0):
    b, t, _ = h.shape
    dt = h.dtype
    f32 = jnp.float32
    (nq, nk, nv, rq, rk, rv, rg, mq, mk, mv, mo, mgate, gate_pre) = jnp.split(h @ lw['w_in'], IN_SPLITS, axis=-1)
    nq = rms_norm(nq.reshape(b, t, NA_HEADS, NA_HEAD_DIM), lw['na_q_g']) * (NA_HEAD_DIM ** -0.5)
    nk = rms_norm(nk.reshape(b, t, NA_HEADS, NA_HEAD_DIM), lw['na_k_g'])
    nv = nv.reshape(b, t, NA_HEADS, NA_HEAD_DIM)
    if latent:
        na = neighborhood_attention(nq, nk, nv, ctx_k, ctx_v, lw['na_rpb'])
    else:
        na = context_attention(nq, nk, nv)
    rq = rq.reshape(b, t, RET_HEADS, RET_DK).astype(f32)
    rk = rk.reshape(b, t, RET_HEADS, RET_DK).astype(f32) * (RET_DK ** -0.5)
    rv = rv.reshape(b, t, RET_HEADS, RET_DV).astype(f32)
    if latent:
        rq = axial_rope(rq)
        rk = axial_rope(rk)
    log_gamma = jax.nn.log_sigmoid(lw['ret_decay'].astype(f32))
    ret_f, rs_f = retention_scan(rq, rk, rv, log_gamma[0], ret_s0[:, 0])
    ret_b, rs_b = retention_scan(_flip(rq), _flip(rk), _flip(rv), log_gamma[1], ret_s0[:, 1])
    ret = rms_norm(ret_f + _flip(ret_b), lw['ret_norm_g'].reshape(RET_HEADS, RET_DV))
    ret = (ret.reshape(b, t, RET_W) * jax.nn.silu(rg.astype(f32))).astype(dt)
    mq = mq.reshape(b, t, M_HEADS, M_DK).astype(f32)
    mk = mk.reshape(b, t, M_HEADS, M_DK).astype(f32) * (M_DK ** -0.5)
    mv = mv.reshape(b, t, M_HEADS, M_DV).astype(f32)
    gates = (mgate + lw['m_gate_b']).astype(f32).reshape(b, t, 4, M_HEADS)
    h_f, c_f, n_f, m_f = mlstm_scan(mq, mk, mv, gates[:, :, 0], gates[:, :, 1], mc0[:, 0], mn0[:, 0], mm0[:, 0])
    h_b, c_b, n_b, m_b = mlstm_scan(_flip(mq), _flip(mk), _flip(mv), _flip(gates[:, :, 2]), _flip(gates[:, :, 3]), mc0[:, 1], mn0[:, 1], mm0[:, 1])
    ml = rms_norm(h_f + _flip(h_b), lw['m_norm_g'].reshape(M_HEADS, M_DV))
    ml = (ml.reshape(b, t, M_W) * jax.nn.sigmoid(mo.astype(f32))).astype(dt)
    g_na, g_ret, g_m = jnp.split(jax.nn.sigmoid(gate_pre), 3, axis=-1)
    mixed = (g_na * (na.reshape(b, t, NA_W) @ lw['w_branch_na'])
             + g_ret * (ret @ lw['w_branch_ret'])
             + g_m * (ml @ lw['w_branch_m']))
    out = mixed @ lw['w_out']
    states = (nk, nv,
              jnp.stack([rs_f, rs_b], axis=1).astype(dt),
              jnp.stack([c_f, c_b], axis=1).astype(dt),
              jnp.stack([n_f, n_b], axis=1).astype(dt),
              jnp.stack([m_f, m_b], axis=1).astype(dt))
    return out, states


def trunk_layer(x, cond, lw, latent, ctx_k, ctx_v, ret_s0, mc0, mn0, mm0):
    mod = jax.nn.silu(cond) @ lw['w_mod'] + lw['b_mod']
    sh1, sc1, g1, sh2, sc2, g2 = jnp.split(mod[:, None, :], 6, axis=-1)
    h = rms_norm(x, lw['norm1_g']) * (1.0 + sc1) + sh1
    mix, states = token_mixers(h, lw, latent, ctx_k, ctx_v, ret_s0, mc0, mn0, mm0)
    x = x + g1 * mix
    h = rms_norm(x, lw['norm2_g']) * (1.0 + sc2) + sh2
    x = x + g2 * (jnp.square(jax.nn.relu(h @ lw['w_ff1'])) @ lw['w_ff2'])
    return x, states


def setup_inputs(seed: int = 0) -> dict:
    key = jax.random.key(seed)
    ks = jax.random.split(key, 32)
    nrm = jax.random.normal
    f32 = jnp.float32
    x_prompt = nrm(ks[0], (BATCH, SEQ, D_MODEL), f32)
    x_sample = nrm(ks[1], (DEC_BATCH, DEC_SEQ, D_MODEL), f32)
    c = nrm(ks[2], (DEC_BATCH, D_MODEL), f32)
    cache_na_k = nrm(ks[3], (DEC_BATCH, DEPTH, PAST_LEN, NA_HEADS, NA_HEAD_DIM), f32)
    cache_na_v = nrm(ks[4], (DEC_BATCH, DEPTH, PAST_LEN, NA_HEADS, NA_HEAD_DIM), f32)
    state_ret = nrm(ks[5], (DEC_BATCH, DEPTH, 2, RET_HEADS, RET_DK, RET_DV), f32)
    state_mlstm_c = 0.1 * nrm(ks[6], (DEC_BATCH, DEPTH, 2, M_HEADS, M_DK, M_DV), f32)
    state_mlstm_n = 0.1 * nrm(ks[7], (DEC_BATCH, DEPTH, 2, M_HEADS, M_DK), f32)
    state_mlstm_m = nrm(ks[8], (DEC_BATCH, DEPTH, 2, M_HEADS), f32)
    c_ctx = nrm(ks[9], (D_MODEL,), f32)
    w_mod = 0.5 * D_MODEL ** -0.5 * nrm(ks[10], (DEPTH, D_MODEL, 6 * D_MODEL), f32)
    b_mod = 0.01 * nrm(ks[11], (DEPTH, 6 * D_MODEL), f32)
    norm1_g = 1.0 + 0.01 * nrm(ks[12], (DEPTH, D_MODEL), f32)
    norm2_g = 1.0 + 0.01 * nrm(ks[13], (DEPTH, D_MODEL), f32)
    w_in = D_MODEL ** -0.5 * nrm(ks[14], (DEPTH, D_MODEL, N_IN), f32)
    i_bias = 0.1 * nrm(ks[15], (DEPTH, 2, M_HEADS), f32)
    f_bias = jnp.linspace(3.0, 6.0, M_HEADS, dtype=f32) + 0.01 * nrm(ks[16], (DEPTH, 2, M_HEADS), f32)
    m_gate_b = jnp.stack([i_bias[:, 0], f_bias[:, 0], i_bias[:, 1], f_bias[:, 1]], axis=1).reshape(DEPTH, N_GATES)
    na_q_g = 1.0 + 0.01 * nrm(ks[17], (DEPTH, NA_HEAD_DIM), f32)
    na_k_g = 1.0 + 0.01 * nrm(ks[18], (DEPTH, NA_HEAD_DIM), f32)
    na_rpb = 0.1 * nrm(ks[19], (DEPTH, NA_HEADS, 2 * NA_WIN_ROWS - 1, 2 * NA_WIN_COLS - 1), f32)
    decay_base = jnp.log(2.0 ** (5.0 + jnp.arange(RET_HEADS, dtype=f32)) - 1.0)
    ret_decay = decay_base + 0.1 * nrm(ks[20], (DEPTH, 2, RET_HEADS), f32)
    ret_norm_g = 1.0 + 0.01 * nrm(ks[21], (DEPTH, RET_W), f32)
    m_norm_g = 1.0 + 0.01 * nrm(ks[22], (DEPTH, M_W), f32)
    w_branch_na = NA_W ** -0.5 * nrm(ks[23], (DEPTH, NA_W, D_MODEL), f32)
    w_branch_ret = RET_W ** -0.5 * nrm(ks[24], (DEPTH, RET_W, D_MODEL), f32)
    w_branch_m = M_W ** -0.5 * nrm(ks[25], (DEPTH, M_W, D_MODEL), f32)
    w_out = D_MODEL ** -0.5 * nrm(ks[26], (DEPTH, D_MODEL, D_MODEL), f32)
    w_ff1 = D_MODEL ** -0.5 * nrm(ks[27], (DEPTH, D_MODEL, D_FF), f32)
    w_ff2 = D_FF ** -0.5 * nrm(ks[28], (DEPTH, D_FF, D_MODEL), f32)
    return {'x_prompt': x_prompt, 'x_sample': x_sample, 'c': c,
            'cache_na_k': cache_na_k, 'cache_na_v': cache_na_v, 'state_ret': state_ret,
            'state_mlstm_c': state_mlstm_c, 'state_mlstm_n': state_mlstm_n, 'state_mlstm_m': state_mlstm_m,
            'c_ctx': c_ctx, 'w_mod': w_mod, 'b_mod': b_mod, 'norm1_g': norm1_g, 'norm2_g': norm2_g,
            'w_in': w_in, 'm_gate_b': m_gate_b, 'na_q_g': na_q_g, 'na_k_g': na_k_g, 'na_rpb': na_rpb,
            'ret_decay': ret_decay, 'ret_norm_g': ret_norm_g, 'm_norm_g': m_norm_g,
            'w_branch_na': w_branch_na, 'w_branch_ret': w_branch_ret, 'w_branch_m': w_branch_m,
            'w_out': w_out, 'w_ff1': w_ff1, 'w_ff2': w_ff2}


def reference(x_prompt, x_sample, c, cache_na_k, cache_na_v, state_ret, state_mlstm_c, state_mlstm_n, state_mlstm_m,
              c_ctx, w_mod, b_mod, norm1_g, norm2_g, w_in, m_gate_b, na_q_g, na_k_g, na_rpb, ret_decay,
              ret_norm_g, m_norm_g, w_branch_na, w_branch_ret, w_branch_m, w_out, w_ff1, w_ff2):
    bp = x_prompt.shape[0]
    f32 = jnp.float32
    zero_ret = jnp.zeros((bp, 2, RET_HEADS, RET_DK, RET_DV), f32)
    zero_c = jnp.zeros((bp, 2, M_HEADS, M_DK, M_DV), f32)
    zero_n = jnp.zeros((bp, 2, M_HEADS, M_DK), f32)
    zero_m = jnp.zeros((bp, 2, M_HEADS), f32)
    yp, ys = x_prompt, x_sample
    na_k_l, na_v_l, ret_l, mc_l, mn_l, mm_l = [], [], [], [], [], []
    for l in range(DEPTH):
        lw = dict(w_mod=w_mod[l], b_mod=b_mod[l], norm1_g=norm1_g[l], norm2_g=norm2_g[l], w_in=w_in[l],
                  m_gate_b=m_gate_b[l], na_q_g=na_q_g[l], na_k_g=na_k_g[l], na_rpb=na_rpb[l],
                  ret_decay=ret_decay[l], ret_norm_g=ret_norm_g[l], m_norm_g=m_norm_g[l],
                  w_branch_na=w_branch_na[l], w_branch_ret=w_branch_ret[l], w_branch_m=w_branch_m[l],
                  w_out=w_out[l], w_ff1=w_ff1[l], w_ff2=w_ff2[l])
        yp, (nk, nv, rs, mc, mn, mm) = trunk_layer(yp, c_ctx[None, :], lw, False, None, None,
                                                   zero_ret, zero_c, zero_n, zero_m)
        na_k_l.append(nk)
        na_v_l.append(nv)
        ret_l.append(rs)
        mc_l.append(mc)
        mn_l.append(mn)
        mm_l.append(mm)
        ys, _ = trunk_layer(ys, c, lw, True, cache_na_k[:, l], cache_na_v[:, l], state_ret[:, l],
                            state_mlstm_c[:, l], state_mlstm_n[:, l], state_mlstm_m[:, l])
    new_na_k = jnp.stack(na_k_l, axis=1)
    new_na_v = jnp.stack(na_v_l, axis=1)
    new_ret = jnp.stack(ret_l, axis=1)
    new_mlstm_c = jnp.stack(mc_l, axis=1)
    new_mlstm_n = jnp.stack(mn_l, axis=1)
    new_mlstm_m = jnp.stack(mm_l, axis=1)
    return (yp, ys, new_na_k, new_na_v, new_ret, new_mlstm_c, new_mlstm_n, new_mlstm_m)
```

```cpp
#include <hip/hip_runtime.h>
#include <hip/hip_cooperative_groups.h>
#include <cstdio>
#include <cstdint>
namespace cg = cooperative_groups;

#define LAS __attribute__((address_space(3)))
typedef unsigned short bf16_t;
typedef short bf16x8 __attribute__((ext_vector_type(8)));
typedef short s16x4 __attribute__((ext_vector_type(4)));
typedef short v4i16_t __attribute__((ext_vector_type(4)));
typedef float f32x4 __attribute__((ext_vector_type(4)));
typedef unsigned u32x4 __attribute__((ext_vector_type(4)));
typedef unsigned u32x2 __attribute__((ext_vector_type(2)));

constexpr int D = 2048, MROWS = 20480, MCTX = 4096;
constexpr int NQKV = 11264, NGATE = 6144, NPROJ = 17664, FFD = 8192;
constexpr int NTHREADS = 512;
constexpr int LDS_BYTES = 135168;

constexpr size_t WS_WBR   = 0;
constexpr size_t WS_WOUT3 = WS_WBR + 6144ull * 1024 * 2;
constexpr size_t WS_FF1   = WS_WOUT3 + 2048ull * 6144 * 2;
constexpr size_t WS_FF2   = WS_FF1 + 8192ull * 2048 * 2;
constexpr size_t WS_R1    = WS_FF2 + 2048ull * 8192 * 2;
constexpr size_t WS_R2    = WS_R1 + (size_t)MROWS * 1024 * 2 * 4;
constexpr size_t WS_R3    = WS_R2 + (size_t)MROWS * NQKV * 2;
constexpr size_t WS_R4    = WS_R3 + (size_t)MROWS * NGATE * 2;
constexpr size_t WS_MGATE = WS_R4 + (size_t)MROWS * 3072 * 2;
constexpr size_t WS_MOD   = WS_MGATE + (size_t)MROWS * 32 * 4;
constexpr size_t WS_ROPE  = WS_MOD + 2ull * 5 * 12288 * 4;
constexpr size_t WS_CK    = WS_ROPE + 2ull * 2048 * 4;
constexpr size_t WS_CV    = WS_CK + 4ull * 2 * 512 * 1024 * 2;
constexpr size_t WS_CTR   = WS_CV + 4ull * 2 * 512 * 1024 * 2;
constexpr size_t WS_BAR   = WS_CTR + 256;
constexpr size_t WS_END   = WS_BAR + 16128;

constexpr size_t OUT_NAK = 41943040, OUT_NAV = 50331648, OUT_RET = 58720256, OUT_MC = 67108864, OUT_MN = 75497472, OUT_MM = 75563008;

struct Params { const float* in[28]; float* out; unsigned char* ws; };

__device__ __forceinline__ int otid() { int t = threadIdx.x; asm volatile("" : "+v"(t)); return t; }
__device__ __forceinline__ unsigned pk2(float lo, float hi) { unsigned r; asm("v_cvt_pk_bf16_f32 %0, %1, %2" : "=v"(r) : "v"(lo), "v"(hi)); return r; }
__device__ __forceinline__ unsigned f2bf(float f) { return pk2(f, f) & 0xffffu; }
__device__ __forceinline__ float bflo(unsigned w) { return __builtin_bit_cast(float, w << 16); }
__device__ __forceinline__ float bfhi(unsigned w) { return __builtin_bit_cast(float, w & 0xffff0000u); }
__device__ __forceinline__ float bf2f(unsigned short h) { return __builtin_bit_cast(float, (unsigned)h << 16); }
__device__ __forceinline__ float sigm(float x) { return 1.f / (1.f + __expf(-x)); }
__device__ __forceinline__ void unpack8(const u32x4 w, float* f) {
    f[0] = bflo(w.x); f[1] = bfhi(w.x); f[2] = bflo(w.y); f[3] = bfhi(w.y); f[4] = bflo(w.z); f[5] = bfhi(w.z); f[6] = bflo(w.w); f[7] = bfhi(w.w);
}
__device__ __forceinline__ u32x4 pack8(const float* f) { u32x4 w; w.x = pk2(f[0], f[1]); w.y = pk2(f[2], f[3]); w.z = pk2(f[4], f[5]); w.w = pk2(f[6], f[7]); return w; }
__device__ __forceinline__ s16x4 trr(LAS const unsigned char* p) { return __builtin_bit_cast(s16x4, __builtin_amdgcn_ds_read_tr16_b64_v4i16((LAS v4i16_t*)p)); }
__device__ __forceinline__ bf16x8 cat4(s16x4 a, s16x4 b) { bf16x8 r; r[0] = a[0]; r[1] = a[1]; r[2] = a[2]; r[3] = a[3]; r[4] = b[0]; r[5] = b[1]; r[6] = b[2]; r[7] = b[3]; return r; }

namespace pg8 {
constexpr int BM = 256, BK = 64, HALF = 128, HTB = HALF * BK * 2, STAGE_BYTES = 8 * HTB, NXCD = 8, WGM = 8;
__host__ __device__ __forceinline__ int lds_byte(int r, int c) { const int st = (r >> 4) * 2 + (c >> 5), rr = r & 15, cc = c & 31, ob = rr * 64 + cc * 2; return st * 1024 + (ob ^ (((ob >> 9) & 1) << 5)); }
__host__ __device__ __forceinline__ void stage_rc(int b, int& R, int& C) { const int st = b / 1024, sb = b % 1024, swz = sb ^ (((sb >> 9) & 1) << 5); R = (st >> 1) * 16 + swz / 64; C = (st & 1) * 32 + (swz % 64) / 2; }
__host__ __device__ __forceinline__ int perm32(int rho) { const int n = rho >> 4, i = rho & 15; return 8 * (i >> 2) + 4 * n + (i & 3); }
struct Unit { int pm, pn, ab, bn, k0, nt; };
struct Gemm { const bf16_t* A; const bf16_t* Bt; int M, N, K, lda, acs; };
struct StaticOrder {
    int nM, nN, nwg, G, c, ntk;
    __device__ void init(int M, int N, int K, int G_, int c_) { nM = M / BM; nN = N / BM; nwg = nM * nN; G = G_; c = c_; ntk = K / BK; }
    __device__ bool next(int i, Unit& u) const {
        const long L = (long)i * G + c; if (L >= nwg) return false;
        int wgid = (int)L; { const int q = nwg / NXCD, r = nwg % NXCD, xcd = wgid % NXCD, off = wgid / NXCD; wgid = (xcd < r ? xcd * (q + 1) : r * (q + 1) + (xcd - r) * q) + off; }
        const int nig = WGM * nN, gid = wgid / nig, fm = gid * WGM, gsz = (nM - fm) < WGM ? (nM - fm) : WGM;
        u.pm = fm + ((wgid % nig) % gsz); u.pn = (wgid % nig) / gsz; u.ab = 0; u.bn = u.pn; u.k0 = 0; u.nt = ntk; return true;
    }
};
struct BranchOrder {
    int nM, nN, nwg, G, c, ntk;
    __device__ void init(int M, int N, int K, int G_, int c_) { nM = M / BM; nN = N / BM; nwg = nM * nN; G = G_; c = c_; ntk = K / BK; }
    __device__ bool next(int i, Unit& u) const {
        const int br = i % 3; const long L = (long)(i / 3) * G + c; if (L >= nwg) return false;
        int wgid = (int)L; { const int q = nwg / NXCD, r = nwg % NXCD, xcd = wgid % NXCD, off = wgid / NXCD; wgid = (xcd < r ? xcd * (q + 1) : r * (q + 1) + (xcd - r) * q) + off; }
        const int nig = WGM * nN, gid = wgid / nig, fm = gid * WGM, gsz = (nM - fm) < WGM ? (nM - fm) : WGM;
        u.pm = fm + ((wgid % nig) % gsz); u.pn = (wgid % nig) / gsz; u.ab = br; u.bn = br * nN + u.pn; u.k0 = 0; u.nt = ntk; return true;
    }
};

struct SplitTailOrder {
    int nM, nN, nMf, nfull, G, c, ntk;
    __device__ void init(int M, int N, int K, int nMf_, int G_, int c_) { nM = M / BM; nN = N / BM; nMf = nMf_; nfull = nMf * nN; G = G_; c = c_; ntk = K / BK; }
    __device__ bool next(int i, Unit& u) const {
        const long L = (long)i * G + c;
        if (L < nfull) {
            int wgid = (int)L; { const int q = nfull / NXCD, r = nfull % NXCD, xcd = wgid % NXCD, off = wgid / NXCD; wgid = (xcd < r ? xcd * (q + 1) : r * (q + 1) + (xcd - r) * q) + off; }
            const int nig = WGM * nN, gid = wgid / nig, fm = gid * WGM, gsz = (nMf - fm) < WGM ? (nMf - fm) : WGM;
            u.pm = fm + ((wgid % nig) % gsz); u.pn = (wgid % nig) / gsz; u.ab = 0; u.bn = u.pn; u.k0 = 0; u.nt = ntk; return true;
        }
        const long hL = L - nfull; if (hL >= 2L * (nM - nMf) * nN) return false;
        const int half = (int)(hL & 1), tt = (int)(hL >> 1);
        u.pm = nMf + tt / nN; u.pn = tt % nN; u.ab = 1 + half; u.bn = u.pn; u.k0 = half * (ntk / 2) * BK; u.nt = ntk / 2; return true;
    }
};

template <class Epi, class Sched>
__device__ __forceinline__ void gemm_phase(LAS unsigned char* lds, const Gemm g, const Sched& S, const Epi& E) {
    const int tid = otid(), wid = __builtin_amdgcn_readfirstlane(tid >> 6), lane = tid & 63, wr = wid >> 2, wc = wid & 3, fr = lane & 15, fq = lane >> 4;
    const int K = g.K;
    const char* gA = (const char*)g.A; const char* gB = (const char*)g.Bt;
    asm volatile("" : "+s"(gA), "+s"(gB));
    unsigned voffA[2], voffB[2];
#pragma unroll
    for (int i = 0; i < 2; ++i) { int R, C; stage_rc(tid * 16 + i * 8192, R, C); const int Rb = (R & ~31) + perm32(R & 31);
        voffA[i] = (unsigned)(R * g.lda + C) * 2u; voffB[i] = (unsigned)(Rb * K + C) * 2u; }
    const size_t kstep = (size_t)(BK * 2);
    const size_t hstepA = (size_t)HALF * g.lda * 2, hstepB = (size_t)HALF * K * 2;
    const size_t tstepA = 2 * hstepA, tstepB = 2 * hstepB;
    const unsigned ldsw = (unsigned)wid * 1024u;
    const int aoff = lds_byte(wr * 64 + fr, fq * 8), boff = lds_byte(wc * 32 + fr, fq * 8);
#define PG8_SA(b, h) (((b) * 2 + (h)) * HTB)
#define PG8_SB(b, h) ((4 + (b) * 2 + (h)) * HTB)
#define PG8_STAGE(bufoff, gbase, voff) do { _Pragma("unroll") for (int _i = 0; _i < 2; ++_i) \
        __builtin_amdgcn_global_load_lds((const unsigned*)((const char*)(gbase) + (voff)[_i]), (LAS unsigned*)(lds + (bufoff) + ldsw + _i * 8192), 16, 0, 0); } while (0)
#define PG8_LDA(dst, b, h) do { _Pragma("unroll") for (int m = 0; m < 4; ++m) _Pragma("unroll") for (int k = 0; k < 2; ++k) dst[m][k] = *(const LAS bf16x8*)(lds + PG8_SA(b, h) + aoff + m * 2048 + k * 1024); } while (0)
#define PG8_LDB(dst, b, h) do { _Pragma("unroll") for (int n = 0; n < 2; ++n) _Pragma("unroll") for (int k = 0; k < 2; ++k) dst[n][k] = *(const LAS bf16x8*)(lds + PG8_SB(b, h) + boff + n * 2048 + k * 1024); } while (0)
#define PG8_MMA(ai, bj, At, Bt) do { __builtin_amdgcn_s_setprio(1); _Pragma("unroll") for (int m = 0; m < 4; ++m) _Pragma("unroll") for (int n = 0; n < 2; ++n) _Pragma("unroll") for (int k = 0; k < 2; ++k) \
        acc[ai][bj][m][n] = __builtin_amdgcn_mfma_f32_16x16x32_bf16(Bt[n][k], At[m][k], acc[ai][bj][m][n], 0, 0, 0); __builtin_amdgcn_s_setprio(0); } while (0)
#define PG8_WAIT_V(n) asm volatile("s_waitcnt vmcnt(" #n ")" ::: "memory")
#define PG8_WAIT_L(n) asm volatile("s_waitcnt lgkmcnt(" #n ")" ::: "memory")
#define PG8_BAR __builtin_amdgcn_s_barrier()
#define PG8_SCHED __builtin_amdgcn_sched_barrier(0)
    Unit cur, nxt; int ui = 0;
    if (!S.next(0, cur)) return;
    f32x4 acc[2][2][4][2];
#pragma unroll
    for (int a = 0; a < 2; ++a)
#pragma unroll
        for (int b = 0; b < 2; ++b)
#pragma unroll
            for (int m = 0; m < 4; ++m)
#pragma unroll
                for (int n = 0; n < 2; ++n) acc[a][b][m][n] = (f32x4){0.f, 0.f, 0.f, 0.f};
    bf16x8 At[4][2], B0[2][2], B1[2][2];
    const char* cA = gA + (size_t)cur.pm * tstepA + (size_t)cur.ab * g.acs * 2 + (size_t)cur.k0 * 2; const char* cB = gB + (size_t)cur.bn * tstepB + (size_t)cur.k0 * 2;
    PG8_STAGE(PG8_SB(0, 0), cB, voffB); PG8_STAGE(PG8_SB(0, 1), cB + hstepB, voffB); PG8_STAGE(PG8_SA(0, 0), cA, voffA); PG8_STAGE(PG8_SA(0, 1), cA + hstepA, voffA);
    if (wr == 1) PG8_BAR;
    PG8_WAIT_V(2); PG8_BAR;
    PG8_STAGE(PG8_SB(1, 0), cB + kstep, voffB); PG8_STAGE(PG8_SA(1, 0), cA + kstep, voffA); PG8_STAGE(PG8_SB(1, 1), cB + hstepB + kstep, voffB);
    PG8_WAIT_V(6); PG8_BAR;
    for (;;) {
        const bool has_next = S.next(ui + 1, nxt);
        const char* nA = has_next ? gA + (size_t)nxt.pm * tstepA + (size_t)nxt.ab * g.acs * 2 + (size_t)nxt.k0 * 2 : cA; const char* nB = has_next ? gB + (size_t)nxt.bn * tstepB + (size_t)nxt.k0 * 2 : cB;
        const int nt = cur.nt;
        for (int t = 0; t < nt; t += 2) {
            const bool last = (t == nt - 2);
            const char* a1 = cA + (size_t)(t + 1) * kstep;
            const char* a2 = last ? nA : cA + (size_t)(t + 2) * kstep; const char* b2 = last ? nB : cB + (size_t)(t + 2) * kstep;
            const char* a3 = a2 + kstep; const char* b3 = b2 + kstep;
            PG8_LDB(B0, 0, 0); PG8_LDB(B1, 0, 1); PG8_SCHED; PG8_LDA(At, 0, 0); PG8_STAGE(PG8_SA(1, 1), a1 + hstepA, voffA);
            PG8_WAIT_V(8); PG8_WAIT_L(0); PG8_BAR; PG8_MMA(0, 0, At, B0); PG8_MMA(0, 1, At, B1); PG8_BAR; PG8_SCHED;
            PG8_LDA(At, 0, 1); PG8_STAGE(PG8_SB(0, 0), b2, voffB); PG8_STAGE(PG8_SB(0, 1), b2 + hstepB, voffB); PG8_STAGE(PG8_SA(0, 0), a2, voffA);
            PG8_WAIT_V(8); PG8_WAIT_L(0); PG8_BAR; PG8_MMA(1, 0, At, B0); PG8_MMA(1, 1, At, B1); PG8_BAR; PG8_SCHED;
            PG8_LDB(B0, 1, 0); PG8_LDB(B1, 1, 1); PG8_SCHED; PG8_LDA(At, 1, 0); PG8_STAGE(PG8_SA(0, 1), a2 + hstepA, voffA);
            PG8_WAIT_V(8); PG8_WAIT_L(0); PG8_BAR; PG8_MMA(0, 0, At, B0); PG8_MMA(0, 1, At, B1); PG8_BAR; PG8_SCHED;
            PG8_LDA(At, 1, 1); PG8_STAGE(PG8_SB(1, 0), b3, voffB); PG8_STAGE(PG8_SB(1, 1), b3 + hstepB, voffB); PG8_STAGE(PG8_SA(1, 0), a3, voffA);
            PG8_WAIT_V(8); PG8_WAIT_L(0); PG8_BAR; PG8_MMA(1, 0, At, B0); PG8_MMA(1, 1, At, B1); PG8_BAR; PG8_SCHED;
        }
        if (wr == 0) PG8_BAR;
        E(acc, cur, wr, wc, fr, fq);
        if (!has_next) break;
#pragma unroll
        for (int a = 0; a < 2; ++a)
#pragma unroll
            for (int b = 0; b < 2; ++b)
#pragma unroll
                for (int m = 0; m < 4; ++m)
#pragma unroll
                    for (int n = 0; n < 2; ++n) acc[a][b][m][n] = (f32x4){0.f, 0.f, 0.f, 0.f};
        cur = nxt; cA = nA; cB = nB; ++ui;
        if (wr == 1) PG8_BAR;
    }
    PG8_WAIT_V(0);
    PG8_BAR;
#undef PG8_SA
#undef PG8_SB
#undef PG8_STAGE
#undef PG8_LDA
#undef PG8_LDB
#undef PG8_MMA
#undef PG8_WAIT_V
#undef PG8_WAIT_L
#undef PG8_BAR
#undef PG8_SCHED
}
}

struct EpiProj {
    bf16_t* qkv; bf16_t* gates; float* mgate;
    __device__ __forceinline__ void operator()(const f32x4 (&acc)[2][2][4][2], const pg8::Unit& u, int wr, int wc, int fr, int fq) const {
        const int row0 = u.pm * 256 + wr * 64 + fr;
        if (u.pn < 68) {
            bf16_t* base; int ldc, colt;
            if (u.pn < 44) { base = qkv; ldc = NQKV; colt = u.pn * 256; } else { base = gates; ldc = NGATE; colt = (u.pn - 44) * 256; }
            const int col0 = colt + wc * 32 + 8 * fq;
#pragma unroll
            for (int ai = 0; ai < 2; ++ai)
#pragma unroll
                for (int m = 0; m < 4; ++m) { bf16_t* rowp = base + (size_t)(row0 + ai * 128 + m * 16) * ldc + col0;
#pragma unroll
                    for (int bj = 0; bj < 2; ++bj) { const f32x4 v0 = acc[ai][bj][m][0], v1 = acc[ai][bj][m][1];
                        u32x4 w; w.x = pk2(v0[0], v0[1]); w.y = pk2(v0[2], v0[3]); w.z = pk2(v1[0], v1[1]); w.w = pk2(v1[2], v1[3]);
                        *(u32x4*)(rowp + bj * 128) = w; } }
        } else if (wc == 0) {
#pragma unroll
            for (int ai = 0; ai < 2; ++ai)
#pragma unroll
                for (int m = 0; m < 4; ++m) { float* rowp = mgate + (size_t)(row0 + ai * 128 + m * 16) * 32 + 8 * fq;
                    *(f32x4*)rowp = acc[ai][0][m][0]; *(f32x4*)(rowp + 4) = acc[ai][0][m][1]; }
        }
    }
};
struct EpiBranch {
    const bf16_t* gates; bf16_t* tmp; bf16_t* mixed;
    __device__ __forceinline__ void operator()(const f32x4 (&acc)[2][2][4][2], const pg8::Unit& u, int wr, int wc, int fr, int fq) const {
        const int row0 = u.pm * 256 + wr * 64 + fr, col0 = u.pn * 256 + wc * 32 + 8 * fq, br = u.ab;
        bf16_t* dstb = (br < 2) ? tmp : mixed;
#pragma unroll
        for (int ai = 0; ai < 2; ++ai)
#pragma unroll
            for (int m = 0; m < 4; ++m) { const size_t row = (size_t)(row0 + ai * 128 + m * 16);
#pragma unroll
                for (int bj = 0; bj < 2; ++bj) { f32x4 v0 = acc[ai][bj][m][0], v1 = acc[ai][bj][m][1];
                    const u32x4 gw = *(const u32x4*)(gates + row * NGATE + br * D + col0 + bj * 128); float gf[8]; unpack8(gw, gf);
#pragma unroll
                    for (int e = 0; e < 4; ++e) { v0[e] *= sigm(gf[e]); v1[e] *= sigm(gf[4 + e]); }
                    const size_t eo = row * D + col0 + bj * 128;
                    if (br > 0) { float pf[8]; unpack8(*(const u32x4*)(tmp + eo), pf);
#pragma unroll
                        for (int e = 0; e < 4; ++e) { v0[e] += pf[e]; v1[e] += pf[4 + e]; } }
                    u32x4 w; w.x = pk2(v0[0], v0[1]); w.y = pk2(v0[2], v0[3]); w.z = pk2(v1[0], v1[1]); w.w = pk2(v1[2], v1[3]);
                    *(u32x4*)(dstb + eo) = w; } }
    }
};
struct EpiResid {
    const float* xa; const float* xb; float* xo; const float* mod; int goff;
    __device__ __forceinline__ void operator()(const f32x4 (&acc)[2][2][4][2], const pg8::Unit& u, int wr, int wc, int fr, int fq) const {
        const int row0 = u.pm * 256 + wr * 64 + fr, col0 = u.pn * 256 + wc * 32 + 8 * fq;
        const int mr = (u.pm < 16) ? 0 : 1 + ((u.pm - 16) >> 4);
        const float* gp_ = mod + (size_t)mr * 12288 + goff + col0;
        f32x4 g[2][2];
#pragma unroll
        for (int bj = 0; bj < 2; ++bj) { g[bj][0] = *(const f32x4*)(gp_ + bj * 128); g[bj][1] = *(const f32x4*)(gp_ + bj * 128 + 4); }
#pragma unroll
        for (int ai = 0; ai < 2; ++ai)
#pragma unroll
            for (int m = 0; m < 4; ++m) { const int row = row0 + ai * 128 + m * 16;
                const float* xi = (row < MCTX ? xa + (size_t)row * D : xb + (size_t)(row - MCTX) * D) + col0; float* xw = xo + (size_t)row * D + col0;
#pragma unroll
                for (int bj = 0; bj < 2; ++bj) { const f32x4 x0 = *(const f32x4*)(xi + bj * 128), x1 = *(const f32x4*)(xi + bj * 128 + 4);
                    *(f32x4*)(xw + bj * 128) = x0 + g[bj][0] * acc[ai][bj][m][0]; *(f32x4*)(xw + bj * 128 + 4) = x1 + g[bj][1] * acc[ai][bj][m][1]; } }
    }
};
struct EpiResidSplit {
    float* x; float* part; const float* mod; int goff;
    __device__ __forceinline__ void operator()(const f32x4 (&acc)[2][2][4][2], const pg8::Unit& u, int wr, int wc, int fr, int fq) const {
        const int row0 = u.pm * 256 + wr * 64 + fr, col0 = u.pn * 256 + wc * 32 + 8 * fq;
        const int mr = (u.pm < 16) ? 0 : 1 + ((u.pm - 16) >> 4);
        const float* gp_ = mod + (size_t)mr * 12288 + goff + col0;
        f32x4 g[2][2];
#pragma unroll
        for (int bj = 0; bj < 2; ++bj) { g[bj][0] = *(const f32x4*)(gp_ + bj * 128); g[bj][1] = *(const f32x4*)(gp_ + bj * 128 + 4); }
        const bool full = (u.ab == 0);
        float* base = full ? x : part + (size_t)(u.ab - 1) * 4096 * D - (size_t)16384 * D;
#pragma unroll
        for (int ai = 0; ai < 2; ++ai)
#pragma unroll
            for (int m = 0; m < 4; ++m) { const int row = row0 + ai * 128 + m * 16; float* xw = base + (size_t)row * D + col0;
#pragma unroll
                for (int bj = 0; bj < 2; ++bj) { f32x4 v0 = g[bj][0] * acc[ai][bj][m][0], v1 = g[bj][1] * acc[ai][bj][m][1];
                    if (full) { v0 += *(const f32x4*)(xw + bj * 128); v1 += *(const f32x4*)(xw + bj * 128 + 4); }
                    *(f32x4*)(xw + bj * 128) = v0; *(f32x4*)(xw + bj * 128 + 4) = v1; } }
    }
};
struct EpiRelu2 {
    bf16_t* o;
    __device__ __forceinline__ void operator()(const f32x4 (&acc)[2][2][4][2], const pg8::Unit& u, int wr, int wc, int fr, int fq) const {
        const int row0 = u.pm * 256 + wr * 64 + fr, col0 = u.pn * 256 + wc * 32 + 8 * fq;
#pragma unroll
        for (int ai = 0; ai < 2; ++ai)
#pragma unroll
            for (int m = 0; m < 4; ++m) { bf16_t* rowp = o + (size_t)(row0 + ai * 128 + m * 16) * FFD + col0;
#pragma unroll
                for (int bj = 0; bj < 2; ++bj) { f32x4 v0 = acc[ai][bj][m][0], v1 = acc[ai][bj][m][1];
#pragma unroll
                    for (int e = 0; e < 4; ++e) { v0[e] = fmaxf(v0[e], 0.f); v0[e] *= v0[e]; v1[e] = fmaxf(v1[e], 0.f); v1[e] *= v1[e]; }
                    u32x4 w; w.x = pk2(v0[0], v0[1]); w.y = pk2(v0[2], v0[3]); w.z = pk2(v1[0], v1[1]); w.w = pk2(v1[2], v1[3]);
                    *(u32x4*)(rowp + bj * 128) = w; } }
    }
};

__device__ __forceinline__ void conv_mat(const float* __restrict__ W, int ldw, int K, int n0, int ncols, bf16_t* WT, int ldt, int row0, int col0, LAS float* tile) {
    const int tid = otid();
    const int ntk = K / 64, nt = (ncols / 64) * ntk;
    for (int t = blockIdx.x; t < nt; t += gridDim.x) {
        const int tk = t % ntk, tn = t / ntk;
        const int kk = tid >> 4, n4 = (tid & 15) * 4;
#pragma unroll
        for (int h = 0; h < 2; ++h) {
            const int k = tk * 64 + kk + h * 32;
            const f32x4 v = *(const f32x4*)(W + (size_t)k * ldw + n0 + tn * 64 + n4);
            tile[(n4 + 0) * 65 + kk + h * 32] = v[0]; tile[(n4 + 1) * 65 + kk + h * 32] = v[1]; tile[(n4 + 2) * 65 + kk + h * 32] = v[2]; tile[(n4 + 3) * 65 + kk + h * 32] = v[3];
        }
        __syncthreads();
        const int nl = tid >> 3, k8 = (tid & 7) * 8;
        float f[8];
#pragma unroll
        for (int j = 0; j < 8; ++j) f[j] = tile[nl * 65 + k8 + j];
        *(u32x4*)(WT + (size_t)(row0 + tn * 64 + nl) * ldt + col0 + tk * 64 + k8) = pack8(f);
        __syncthreads();
    }
}
__device__ __forceinline__ void conv_layer(const Params& p, int l, LAS unsigned char* lds) {
    LAS float* tile = (LAS float*)lds;
    unsigned char* ws = p.ws;
    bf16_t* WinT = (bf16_t*)(ws + WS_R4);
    const float* w_in = p.in[14] + (size_t)l * D * 17440;
    conv_mat(w_in, 17440, D, 0, 11264, WinT, D, 0, 0, tile);
    conv_mat(w_in, 17440, D, 11296, 6144, WinT, D, 11264, 0, tile);
    for (int i = blockIdx.x * NTHREADS + threadIdx.x; i < 32 * D; i += gridDim.x * NTHREADS) { const int n = i >> 11, k = i & 2047; WinT[(size_t)(17408 + n) * D + k] = (bf16_t)f2bf(w_in[(size_t)k * 17440 + 11264 + n]); }
    bf16_t* wbr = (bf16_t*)(ws + WS_WBR);
    for (int br = 0; br < 3; ++br) conv_mat(p.in[22 + br] + (size_t)l * 1024 * D, D, 1024, 0, D, wbr, 1024, br * D, 0, tile);
    conv_mat(p.in[25] + (size_t)l * D * D, D, D, 0, D, (bf16_t*)(ws + WS_WOUT3), D, 0, 0, tile);
    conv_mat(p.in[26] + (size_t)l * D * FFD, FFD, D, 0, FFD, (bf16_t*)(ws + WS_FF1), D, 0, 0, tile);
    conv_mat(p.in[27] + (size_t)l * FFD * D, D, FFD, 0, D, (bf16_t*)(ws + WS_FF2), FFD, 0, 0, tile);
}

__device__ __forceinline__ void p0_misc(const Params& p, LAS unsigned char* lds) {
    const int tid = otid();
    unsigned char* ws = p.ws;
    LAS float* sc = (LAS float*)lds;
    LAS float* red = (LAS float*)(lds + 40960);
    for (int i = tid; i < 5 * D; i += NTHREADS) { const int r = i >> 11, k = i & 2047; const float v = (r == 0) ? p.in[9][k] : p.in[2][(r - 1) * D + k]; sc[i] = v / (1.f + __expf(-v)); }
    __syncthreads();
    float* MOD = (float*)(ws + WS_MOD);
    for (int item = blockIdx.x; item < 768; item += gridDim.x) {
        const int kh = item & 1, it2 = item >> 1, l = it2 / 192, cb = it2 % 192, cl = tid & 63, kg = tid >> 6;
        const int kbase = kh * 1024 + kg * 128;
        const float* w = p.in[10] + (size_t)l * D * 12288 + (size_t)kbase * 12288 + cb * 64 + cl;
        float a0 = 0.f, a1 = 0.f, a2 = 0.f, a3 = 0.f, a4 = 0.f;
#pragma unroll 1
        for (int i0 = 0; i0 < 128; i0 += 32) {
            float wv[32];
#pragma unroll
            for (int i = 0; i < 32; ++i) wv[i] = w[(size_t)(i0 + i) * 12288];
#pragma unroll
            for (int i = 0; i < 32; ++i) { const int k = kbase + i0 + i;
                a0 += sc[k] * wv[i]; a1 += sc[D + k] * wv[i]; a2 += sc[2 * D + k] * wv[i]; a3 += sc[3 * D + k] * wv[i]; a4 += sc[4 * D + k] * wv[i]; }
        }
        red[(kg * 5 + 0) * 64 + cl] = a0; red[(kg * 5 + 1) * 64 + cl] = a1; red[(kg * 5 + 2) * 64 + cl] = a2; red[(kg * 5 + 3) * 64 + cl] = a3; red[(kg * 5 + 4) * 64 + cl] = a4;
        __syncthreads();
        if (tid < 320) { const int r = tid >> 6; float s = 0.f;
#pragma unroll
            for (int g = 0; g < 8; ++g) s += red[(g * 5 + r) * 64 + cl];
            if (kh == 0) s += p.in[11][l * 12288 + cb * 64 + cl];
            atomicAdd(&MOD[(size_t)(l * 5 + r) * 12288 + cb * 64 + cl], s); }
        __syncthreads();
    }
    { const int i = blockIdx.x * NTHREADS + tid; if (i < 2048) { const int pos = i >> 5, fi = i & 31; const float inv = expf(-(float)fi * (9.210340371976184f / 32.f)); const float ang = (float)pos * inv;
        float* rp = (float*)(ws + WS_ROPE); rp[i] = cosf(ang); rp[2048 + i] = sinf(ang); } }
    { u32x2* ck = (u32x2*)(ws + WS_CK); u32x2* cv = (u32x2*)(ws + WS_CV); const f32x4* sk = (const f32x4*)p.in[3]; const f32x4* sv = (const f32x4*)p.in[4];
      for (int i = blockIdx.x * NTHREADS + tid; i < 1048576; i += gridDim.x * NTHREADS) { const f32x4 a = sk[i], b = sv[i]; u32x2 x, y; x.x = pk2(a[0], a[1]); x.y = pk2(a[2], a[3]); y.x = pk2(b[0], b[1]); y.y = pk2(b[2], b[3]); ck[i] = x; cv[i] = y; } }
}

__device__ __forceinline__ void norm_mod_phase(const float* xa, const float* xb, const float* g, const float* mod, int sh_off, int sc_off, bf16_t* H, const float* fix, float* xfix) {
    const int tid_ = otid(); const int lane = tid_ & 63, wave = tid_ >> 6;
    const int stride = gridDim.x * 8;
    for (int row0 = blockIdx.x * 8 + wave; row0 < MROWS; row0 += 2 * stride) {
        const int row1 = row0 + stride; const bool has1 = row1 < MROWS;
        const float* x0 = row0 < MCTX ? xa + (size_t)row0 * D : xb + (size_t)(row0 - MCTX) * D;
        const int r1c = has1 ? row1 : row0;
        const float* x1 = r1c < MCTX ? xa + (size_t)r1c * D : xb + (size_t)(r1c - MCTX) * D;
        f32x4 v[2][8];
#pragma unroll
        for (int i = 0; i < 8; ++i) { v[0][i] = *(const f32x4*)(x0 + i * 256 + lane * 4); v[1][i] = *(const f32x4*)(x1 + i * 256 + lane * 4); }
#pragma unroll
        for (int rr = 0; rr < 2; ++rr) {
            const int row = rr ? r1c : row0;
            if (rr == 1 && !has1) break;
            if (fix != nullptr && row >= 16384) { const float* f0 = fix + (size_t)(row - 16384) * D; const float* f1 = f0 + (size_t)4096 * D; float* xw = xfix + (size_t)row * D;
#pragma unroll
                for (int i = 0; i < 8; ++i) { v[rr][i] += *(const f32x4*)(f0 + i * 256 + lane * 4) + *(const f32x4*)(f1 + i * 256 + lane * 4); *(f32x4*)(xw + i * 256 + lane * 4) = v[rr][i]; } }
            float ss = 0.f;
#pragma unroll
            for (int i = 0; i < 8; ++i) ss += v[rr][i][0] * v[rr][i][0] + v[rr][i][1] * v[rr][i][1] + v[rr][i][2] * v[rr][i][2] + v[rr][i][3] * v[rr][i][3];
#pragma unroll
            for (int o = 32; o >= 1; o >>= 1) ss += __shfl_xor(ss, o);
            const float rs = rsqrtf(ss * (1.f / 2048.f) + 1e-6f);
            const float* m = mod + (size_t)(row < MCTX ? 0 : 1 + ((row - MCTX) >> 12)) * 12288;
#pragma unroll
            for (int i = 0; i < 8; ++i) { const int e = i * 256 + lane * 4;
                const f32x4 gg = *(const f32x4*)(g + e), sc = *(const f32x4*)(m + sc_off + e), sh = *(const f32x4*)(m + sh_off + e);
                const f32x4 y = v[rr][i] * rs * gg * (sc + 1.f) + sh;
                u32x2 w; w.x = pk2(y[0], y[1]); w.y = pk2(y[2], y[3]);
                *(u32x2*)(H + (size_t)row * D + e) = w; }
        }
    }
}

__device__ __forceinline__ void finalize_phase(const bf16_t* OF, const bf16_t* QKV, const float* rg_, const float* mg_, bf16_t* MIX) {
    const int tid_ = otid(); const int lane = tid_ & 63, wave = tid_ >> 6;
    for (int row = blockIdx.x * 8 + wave; row < MROWS; row += gridDim.x * 8) {
#pragma unroll
        for (int mx = 0; mx < 2; ++mx) {
            const bf16_t* f = OF + (size_t)(mx * 2) * MROWS * 1024 + (size_t)row * 1024 + lane * 16;
            const bf16_t* b = f + (size_t)MROWS * 1024;
            const bf16_t* gt = QKV + (size_t)row * NQKV + (mx == 0 ? 6144 : 10240) + lane * 16;
            const float* ng = (mx == 0 ? rg_ : mg_) + lane * 16;
            float v[16], t[8];
            unpack8(*(const u32x4*)f, v); unpack8(*(const u32x4*)(f + 8), v + 8);
            unpack8(*(const u32x4*)b, t);
#pragma unroll
            for (int i = 0; i < 8; ++i) v[i] += t[i];
            unpack8(*(const u32x4*)(b + 8), t);
#pragma unroll
            for (int i = 0; i < 8; ++i) v[8 + i] += t[i];
            float ss = 0.f;
#pragma unroll
            for (int i = 0; i < 16; ++i) ss += v[i] * v[i];
            ss += __shfl_xor(ss, 1); ss += __shfl_xor(ss, 2); ss += __shfl_xor(ss, 4);
            const float rs = rsqrtf(ss * (1.f / 128.f) + 1e-6f);
            float gv[16];
            unpack8(*(const u32x4*)gt, gv); unpack8(*(const u32x4*)(gt + 8), gv + 8);
            float o[16];
#pragma unroll
            for (int i = 0; i < 16; ++i) { const float s = sigm(gv[i]); const float gate = (mx == 0) ? gv[i] * s : s; o[i] = v[i] * rs * ng[i] * gate; }
            bf16_t* dst = MIX + (size_t)row * 3072 + 1024 + mx * 1024 + lane * 16;
            *(u32x4*)dst = pack8(o); *(u32x4*)(dst + 8) = pack8(o + 8);
        }
    }
}

constexpr int RS = 272;
constexpr int L_QT = 0, L_KT = 17408, L_KS = 34816, L_VT = 52224, L_ST = 69632, L_VEC = 104448  , L_NV = 107520, L_RPB = 108032, L_NXT = 109952, L_NP = 110080;
constexpr int L_KT1 = 52224, L_VT0 = 34816, L_VT1 = 69632;

#define MFMA16(a, b, c) __builtin_amdgcn_mfma_f32_16x16x32_bf16(a, b, c, 0, 0, 0)

__device__ __forceinline__ float mlstm_vectors(LAS float* V, float ip, float fp, float mstate, int lane) {
    const float lf = fminf(fp, 0.f) - log1pf(__expf(-fabsf(fp)));
    float bc = lf;
#pragma unroll
    for (int o = 1; o < 64; o <<= 1) { const float t_ = __shfl_up(bc, o); if (lane >= o) bc += t_; }
    const float u = ip - bc;
    float pm = u;
#pragma unroll
    for (int o = 1; o < 64; o <<= 1) { const float t_ = __shfl_up(pm, o); if (lane >= o) pm = fmaxf(pm, t_); }
    const float mm = fmaxf(mstate, pm);
    const float pm63 = __shfl(pm, 63), bend = __shfl(bc, 63);
    const float mrel = fmaxf(mstate, pm63);
    V[lane] = -mm; V[64 + lane] = -u; V[128 + lane] = mstate - mm; V[192 + lane] = u - mrel; V[256 + lane] = __expf(-(bc + mm));
    if (lane == 0) V[320] = mstate - mrel;
    return bend + mrel;
}

template <bool MLSTM>
__device__ __forceinline__ void scan_unit(const Params& p, LAS unsigned char* lds, int l, int latent, int b, int h, int dir, int c_out0, int c_end) {
    const int tid = otid(), lane = tid & 63, w = __builtin_amdgcn_readfirstlane(tid >> 6), fr = lane & 15, fq = lane >> 4, qs = w & 3, dvh = w >> 2;
    const int tq = (lane & 15) >> 2, tp = lane & 3;
    unsigned char* ws = p.ws;
    const bf16_t* QKV = (const bf16_t*)(ws + WS_R2);
    const float* MG = (const float*)(ws + WS_MGATE);
    const float* ROPE = (const float*)(ws + WS_ROPE);
    bf16_t* OF = (bf16_t*)(ws + WS_R1) + (size_t)((MLSTM ? 2 : 0) + dir) * MROWS * 1024;
    const int T = latent ? 4096 : 256, nch = c_end, row_base = latent ? MCTX + b * 4096 : b * 256;
    const int qcol = (MLSTM ? 7168 : 3072) + h * 128;
    LAS float* NV = (LAS float*)(lds + L_NV);
    LAS float* NP = (LAS float*)(lds + L_NP);
    const bool rope = (!MLSTM) && latent;
    const int ls = tid >> 3, lj = tid & 7, c1 = (lj & 3) + 8 * (lj >> 2), c2 = c1 + 4;

    f32x4 st[8];
    const size_t sidx = (size_t)(((b * 2 + l) * 2 + dir) * 8 + h);
    if (latent) {
        const float* S0 = (MLSTM ? p.in[6] : p.in[5]) + sidx * 16384;
#pragma unroll
        for (int t = 0; t < 8; ++t)
#pragma unroll
            for (int j = 0; j < 4; ++j) st[t][j] = S0[(16 * w + fq * 4 + j) * 128 + 16 * t + fr];
    } else {
#pragma unroll
        for (int t = 0; t < 8; ++t) st[t] = (f32x4){0.f, 0.f, 0.f, 0.f};
    }
#pragma unroll
    for (int t = 0; t < 8; ++t) { u32x2 x; x.x = pk2(st[t][0], st[t][1]); x.y = pk2(st[t][2], st[t][3]); *(LAS u32x2*)(lds + L_ST + (16 * t + fr) * RS + (16 * w + fq * 4) * 2) = x; }
    float mstate = 0.f;
    float gbi = 0.f, gbf = 0.f;
    if (MLSTM) {
        if (tid < 128) NV[tid] = latent ? p.in[7][sidx * 128 + tid] : 0.f;
        mstate = latent ? p.in[8][sidx] : 0.f;
        gbi = p.in[15][l * 32 + (2 * dir) * 8 + h]; gbf = p.in[15][l * 32 + (2 * dir + 1) * 8 + h];
    } else {
        if (tid < 128) { const int t_ = tid & 63; LAS float* V = (LAS float*)(lds + L_VEC + (tid >> 6) * 1536);
            const float dcy = p.in[19][(l * 2 + dir) * 8 + h]; const float lg = fminf(dcy, 0.f) - log1pf(__expf(-fabsf(dcy)));
            V[t_] = t_ * lg; V[64 + t_] = t_ * lg; V[128 + t_] = (t_ + 1) * lg; V[192 + t_] = (63 - t_) * lg; V[256 + t_] = 0.f; if (t_ == 0) V[320] = 64.f * lg; }
    }
    u32x4 pq1 = (u32x4){0u, 0u, 0u, 0u}, pq2 = pq1, pk1, pk2_, pv1, pv2; float gip = 0.f, gfp = 0.f;
#define SC_PREFETCH(cc) do { const int tok_ = dir ? T - 1 - ((cc) * 64 + ls) : (cc) * 64 + ls; const bf16_t* src_ = QKV + (size_t)(row_base + tok_) * NQKV + qcol; \
        if ((cc) >= c_out0) { pq1 = *(const u32x4*)(src_ + c1 * 8); pq2 = *(const u32x4*)(src_ + c2 * 8); } pk1 = *(const u32x4*)(src_ + 1024 + c1 * 8); pk2_ = *(const u32x4*)(src_ + 1024 + c2 * 8); \
        pv1 = *(const u32x4*)(src_ + 2048 + c1 * 8); pv2 = *(const u32x4*)(src_ + 2048 + c2 * 8); \
        if (MLSTM && w == 0) { const int tk_ = dir ? T - 1 - ((cc) * 64 + lane) : (cc) * 64 + lane; const float* mg_ = MG + (size_t)(row_base + tk_) * 32; gip = mg_[(2 * dir) * 8 + h] + gbi; gfp = mg_[(2 * dir + 1) * 8 + h] + gbf; } } while (0)
#define SC_WRITE(cc, V_) do { const int tok_ = dir ? T - 1 - ((cc) * 64 + ls) : (cc) * 64 + ls; float cs_[8], sn_[8], x1_[8], x2_[8]; \
        if (rope) { const int pos_ = (lj < 4) ? (tok_ >> 6) : (tok_ & 63); const float* rp_ = ROPE + pos_ * 32 + 8 * (lj & 3); \
            *(f32x4*)cs_ = *(const f32x4*)rp_; *(f32x4*)(cs_ + 4) = *(const f32x4*)(rp_ + 4); *(f32x4*)sn_ = *(const f32x4*)(rp_ + 2048); *(f32x4*)(sn_ + 4) = *(const f32x4*)(rp_ + 2052); } \
        if ((cc) >= c_out0) { unpack8(pq1, x1_); unpack8(pq2, x2_); \
        if (rope) { _Pragma("unroll") for (int e = 0; e < 8; ++e) { const float a_ = x1_[e], b_ = x2_[e]; x1_[e] = a_ * cs_[e] - b_ * sn_[e]; x2_[e] = b_ * cs_[e] + a_ * sn_[e]; } } \
        *(LAS u32x4*)(lds + L_QT + ls * RS + c1 * 16) = pack8(x1_); *(LAS u32x4*)(lds + L_QT + ls * RS + c2 * 16) = pack8(x2_); } \
        unpack8(pk1, x1_); unpack8(pk2_, x2_); \
        if (rope) { _Pragma("unroll") for (int e = 0; e < 8; ++e) { const float a_ = x1_[e], b_ = x2_[e]; x1_[e] = a_ * cs_[e] - b_ * sn_[e]; x2_[e] = b_ * cs_[e] + a_ * sn_[e]; } } \
        _Pragma("unroll") for (int e = 0; e < 8; ++e) { x1_[e] *= 0.08838834764831845f; x2_[e] *= 0.08838834764831845f; } \
        *(LAS u32x4*)(lds + L_KT + ls * RS + c1 * 16) = pack8(x1_); *(LAS u32x4*)(lds + L_KT + ls * RS + c2 * 16) = pack8(x2_); \
        const float kw_ = __expf((V_)[192 + ls]); \
        _Pragma("unroll") for (int e = 0; e < 8; ++e) { x1_[e] *= kw_; x2_[e] *= kw_; } \
        *(LAS u32x4*)(lds + L_KS + ls * RS + c1 * 16) = pack8(x1_); *(LAS u32x4*)(lds + L_KS + ls * RS + c2 * 16) = pack8(x2_); \
        *(LAS u32x4*)(lds + L_VT + ls * RS + c1 * 16) = pv1; *(LAS u32x4*)(lds + L_VT + ls * RS + c2 * 16) = pv2; } while (0)

    SC_PREFETCH(0);
    if (MLSTM && w == 0) mstate = mlstm_vectors((LAS float*)(lds + L_VEC), gip, gfp, mstate, lane);
    __syncthreads();
    { LAS float* V0 = (LAS float*)(lds + L_VEC); SC_WRITE(0, V0); }
    __syncthreads();

    for (int c = 0; c < nch; ++c) {
        LAS float* VA = (LAS float*)(lds + L_VEC + (c & 1) * 1536); LAS float* VB = VA + 64; LAS float* VE = VA + 128; LAS float* VFL = VA + 256;
        LAS float* VN = (LAS float*)(lds + L_VEC + ((c + 1) & 1) * 1536);
        const bool has_next = (c + 1 < nch);
        if (has_next) SC_PREFETCH(c + 1);
        const float cdec = __expf(VA[320]);
        if (c >= c_out0) {
            bf16x8 qf[4];
#pragma unroll
            for (int ks = 0; ks < 4; ++ks) qf[ks] = *(const LAS bf16x8*)(lds + L_QT + (qs * 16 + fr) * RS + (ks * 32 + fq * 8) * 2);
            f32x4 sacc[4];
#pragma unroll
            for (int kt = 0; kt < 4; ++kt) sacc[kt] = (f32x4){0.f, 0.f, 0.f, 0.f};
#pragma unroll
            for (int ks = 0; ks < 4; ++ks) {
                bf16x8 kf[4];
#pragma unroll
                for (int kt = 0; kt < 4; ++kt) kf[kt] = *(const LAS bf16x8*)(lds + L_KT + (kt * 16 + fr) * RS + (ks * 32 + fq * 8) * 2);
#pragma unroll
                for (int kt = 0; kt < 4; ++kt) sacc[kt] = MFMA16(kf[kt], qf[ks], sacc[kt]);
            }
            const int tql = qs * 16 + fr;
            const float Aq = VA[tql];
            float rowsum = 0.f;
#pragma unroll
            for (int kt = 0; kt < 4; ++kt) { const f32x4 bv = *(const LAS f32x4*)(VB + kt * 16 + fq * 4);
#pragma unroll
                for (int j = 0; j < 4; ++j) { const int s = kt * 16 + fq * 4 + j; const float wgt = (s <= tql) ? __expf(Aq - bv[j]) : 0.f; sacc[kt][j] *= wgt; rowsum += sacc[kt][j]; } }
            bf16x8 pa[2];
#pragma unroll
            for (int pp = 0; pp < 2; ++pp) { const u32x4 x = (u32x4){pk2(sacc[2 * pp][0], sacc[2 * pp][1]), pk2(sacc[2 * pp][2], sacc[2 * pp][3]), pk2(sacc[2 * pp + 1][0], sacc[2 * pp + 1][1]), pk2(sacc[2 * pp + 1][2], sacc[2 * pp + 1][3])}; pa[pp] = __builtin_bit_cast(bf16x8, x); }
            float invq[4] = {1.f, 1.f, 1.f, 1.f};
            if (MLSTM) {
                rowsum += __shfl_xor(rowsum, 16); rowsum += __shfl_xor(rowsum, 32);
                float qn = 0.f;
#pragma unroll
                for (int ks = 0; ks < 4; ++ks) { const f32x4 n0 = *(const LAS f32x4*)(NV + ks * 32 + fq * 8), n1 = *(const LAS f32x4*)(NV + ks * 32 + fq * 8 + 4);
#pragma unroll
                    for (int e = 0; e < 4; ++e) { qn += bf2f((unsigned short)qf[ks][e]) * n0[e]; qn += bf2f((unsigned short)qf[ks][4 + e]) * n1[e]; } }
                qn += __shfl_xor(qn, 16); qn += __shfl_xor(qn, 32);
                const float den = rowsum + __expf(VE[tql]) * qn;
                const float inv = 1.f / fmaxf(fabsf(den), VFL[tql]);
#pragma unroll
                for (int j = 0; j < 4; ++j) invq[j] = __shfl(inv, fq * 4 + j);
            }
            float aw[4];
#pragma unroll
            for (int j = 0; j < 4; ++j) aw[j] = __expf(VE[qs * 16 + fq * 4 + j]);
#pragma unroll
            for (int t = 0; t < 4; ++t) {
                f32x4 o = (f32x4){0.f, 0.f, 0.f, 0.f}, oi = (f32x4){0.f, 0.f, 0.f, 0.f};
                const int dvc = dvh * 64 + t * 16;
#pragma unroll
                for (int pp = 0; pp < 2; ++pp) {
                    const s16x4 r1 = trr(lds + L_VT + (32 * pp + fq * 4 + tq) * RS + (dvc + 4 * tp) * 2), r2 = trr(lds + L_VT + (32 * pp + 16 + fq * 4 + tq) * RS + (dvc + 4 * tp) * 2);
                    o = MFMA16(pa[pp], cat4(r1, r2), o); }
#pragma unroll
                for (int ks = 0; ks < 4; ++ks) { const bf16x8 sf = *(const LAS bf16x8*)(lds + L_ST + (dvc + fr) * RS + (ks * 32 + fq * 8) * 2); oi = MFMA16(qf[ks], sf, oi); }
#pragma unroll
                for (int j = 0; j < 4; ++j) { const int ql = qs * 16 + fq * 4 + j; const int tok = dir ? T - 1 - (c * 64 + ql) : c * 64 + ql;
                    const float val = (o[j] + aw[j] * oi[j]) * invq[j];
                    OF[(size_t)(row_base + tok) * 1024 + h * 128 + dvc + fr] = (bf16_t)f2bf(val); }
            }
        }
#pragma unroll
        for (int t = 0; t < 8; ++t) st[t] *= cdec;
#pragma unroll
        for (int pp = 0; pp < 2; ++pp) {
            const s16x4 a1 = trr(lds + L_KS + (32 * pp + fq * 8 + tq) * RS + (16 * w + 4 * tp) * 2), a2 = trr(lds + L_KS + (32 * pp + fq * 8 + 4 + tq) * RS + (16 * w + 4 * tp) * 2);
            const bf16x8 af = cat4(a1, a2);
#pragma unroll
            for (int t = 0; t < 8; ++t) { const s16x4 b1 = trr(lds + L_VT + (32 * pp + fq * 8 + tq) * RS + (16 * t + 4 * tp) * 2), b2 = trr(lds + L_VT + (32 * pp + fq * 8 + 4 + tq) * RS + (16 * t + 4 * tp) * 2);
                st[t] = MFMA16(af, cat4(b1, b2), st[t]); }
        }
        if (MLSTM) { float na = 0.f; const int d_ = tid & 127, s0_ = (tid >> 7) * 16;
#pragma unroll
            for (int s = 0; s < 16; ++s) na += bf2f(*(const LAS unsigned short*)(lds + L_KS + (s0_ + s) * RS + d_ * 2));
            NP[tid] = na; }
        if (MLSTM && w == 0 && has_next) mstate = mlstm_vectors(VN, gip, gfp, mstate, lane);
        __syncthreads();
        if (c + 1 >= c_out0) {
#pragma unroll
        for (int t = 0; t < 8; ++t) { u32x2 x; x.x = pk2(st[t][0], st[t][1]); x.y = pk2(st[t][2], st[t][3]); *(LAS u32x2*)(lds + L_ST + (16 * t + fr) * RS + (16 * w + fq * 4) * 2) = x; } }
        if (MLSTM && tid < 128) NV[tid] = cdec * NV[tid] + ((NP[tid] + NP[128 + tid]) + (NP[256 + tid] + NP[384 + tid]));
        if (has_next) SC_WRITE(c + 1, VN);
        __syncthreads();
    }
#undef SC_PREFETCH
#undef SC_WRITE
    if (!latent) {
        float* So = p.out + (MLSTM ? OUT_MC : OUT_RET) + sidx * 16384;
#pragma unroll
        for (int t = 0; t < 8; ++t)
#pragma unroll
            for (int j = 0; j < 4; ++j) So[(16 * w + fq * 4 + j) * 128 + 16 * t + fr] = st[t][j];
        if (MLSTM) {
            if (tid < 128) p.out[OUT_MN + sidx * 128 + tid] = NV[tid];
            if (tid == 0) p.out[OUT_MM + sidx] = mstate;
        }
    }
}

constexpr int A_Q = 0, A_K0 = 34816, A_V0 = 52224, A_K1 = 69632, A_V1 = 87040;
template <bool LAT>
__device__ __forceinline__ void attn_unit(const Params& p, LAS unsigned char* lds, int l, int b, int h, int rp) {
    const int tid = otid(), lane = tid & 63, w = __builtin_amdgcn_readfirstlane(tid >> 6), fr = lane & 15, fq = lane >> 4, qs = w & 3;
    const int tq = (lane & 15) >> 2, tp = lane & 3;
    unsigned char* ws = p.ws;
    const bf16_t* QKV = (const bf16_t*)(ws + WS_R2);
    bf16_t* MIX = (bf16_t*)(ws + WS_R4);
    const int s_ = tid >> 3, j_ = tid & 7;
    const int r0 = 2 * rp;
    const int qrow0 = LAT ? MCTX + b * 4096 + r0 * 64 : b * 256 + rp * 128;
    const int rsA = LAT ? min(max(r0 - 4, 0), 56) : 0, rsB = LAT ? min(max(r0 - 3, 0), 56) : 0;
    const int nl = LAT ? rsB + 8 - rsA : 0;
    const int ntiles = LAT ? nl + 8 : 4;
    const int rw = r0 + (w >> 2), rsw = (w >> 2) ? rsB : rsA;
    LAS float* RPB = (LAS float*)(lds + L_RPB);
    if (LAT) { for (int i = tid; i < 465; i += NTHREADS) RPB[i] = p.in[18][(size_t)(l * 8 + h) * 465 + i] * 1.4426950408889634f; }
    float gk[16];
    { const float* g_ = p.in[17] + l * 128 + j_ * 16;
#pragma unroll
      for (int e = 0; e < 4; ++e) { const f32x4 t_ = *(const f32x4*)(g_ + 4 * e); gk[4 * e] = t_[0]; gk[4 * e + 1] = t_[1]; gk[4 * e + 2] = t_[2]; gk[4 * e + 3] = t_[3]; } }
    u32x4 pk0, pk1, pv0, pv1;
#define AT_LOAD(kt_) do { if (LAT && (kt_) >= nl) { const size_t off_ = ((size_t)((b * 2 + l) * 512 + ((kt_) - nl) * 64 + s_)) * 1024 + h * 128 + j_ * 16; \
            const bf16_t* ck_ = (const bf16_t*)(ws + WS_CK) + off_; const bf16_t* cv_ = (const bf16_t*)(ws + WS_CV) + off_; \
            pk0 = *(const u32x4*)ck_; pk1 = *(const u32x4*)(ck_ + 8); pv0 = *(const u32x4*)cv_; pv1 = *(const u32x4*)(cv_ + 8); \
        } else { const int krow_ = LAT ? MCTX + b * 4096 + (rsA + (kt_)) * 64 + s_ : b * 256 + (kt_) * 64 + s_; \
            const bf16_t* src_ = QKV + (size_t)krow_ * NQKV + 1024 + h * 128 + j_ * 16; \
            pk0 = *(const u32x4*)src_; pk1 = *(const u32x4*)(src_ + 8); pv0 = *(const u32x4*)(src_ + 1024); pv1 = *(const u32x4*)(src_ + 1032); } } while (0)
#define AT_STORE(kt_) do { const int kb_ = ((kt_) & 1) ? A_K1 : A_K0, vb_ = ((kt_) & 1) ? A_V1 : A_V0; \
        if (LAT && (kt_) >= nl) { *(LAS u32x4*)(lds + kb_ + s_ * RS + j_ * 32) = pk0; *(LAS u32x4*)(lds + kb_ + s_ * RS + j_ * 32 + 16) = pk1; } \
        else { float x_[16]; unpack8(pk0, x_); unpack8(pk1, x_ + 8); float ss_ = 0.f; \
            _Pragma("unroll") for (int e = 0; e < 16; ++e) ss_ += x_[e] * x_[e]; \
            ss_ += __shfl_xor(ss_, 1); ss_ += __shfl_xor(ss_, 2); ss_ += __shfl_xor(ss_, 4); \
            const float rs_ = rsqrtf(ss_ * (1.f / 128.f) + 1e-6f); \
            _Pragma("unroll") for (int e = 0; e < 16; ++e) x_[e] *= rs_ * gk[e]; \
            *(LAS u32x4*)(lds + kb_ + s_ * RS + j_ * 32) = pack8(x_); *(LAS u32x4*)(lds + kb_ + s_ * RS + j_ * 32 + 16) = pack8(x_ + 8); \
            if (!LAT && rp == 0) { const size_t oo_ = ((size_t)((b * 2 + l) * 256 + (kt_) * 64 + s_)) * 1024 + h * 128 + j_ * 16; \
                float* ok_ = p.out + OUT_NAK + oo_; float* ov_ = p.out + OUT_NAV + oo_; \
                _Pragma("unroll") for (int e = 0; e < 4; ++e) *(f32x4*)(ok_ + 4 * e) = (f32x4){x_[4 * e], x_[4 * e + 1], x_[4 * e + 2], x_[4 * e + 3]}; \
                float vf_[16]; unpack8(pv0, vf_); unpack8(pv1, vf_ + 8); \
                _Pragma("unroll") for (int e = 0; e < 4; ++e) *(f32x4*)(ov_ + 4 * e) = (f32x4){vf_[4 * e], vf_[4 * e + 1], vf_[4 * e + 2], vf_[4 * e + 3]}; } } \
        *(LAS u32x4*)(lds + vb_ + s_ * RS + j_ * 32) = pv0; *(LAS u32x4*)(lds + vb_ + s_ * RS + j_ * 32 + 16) = pv1; } while (0)
    AT_LOAD(0);
    {
        const float* g = p.in[16] + l * 128 + j_ * 16;
#pragma unroll
        for (int hh = 0; hh < 2; ++hh) {
            const int qr = s_ + 64 * hh;
            const bf16_t* src = QKV + (size_t)(qrow0 + qr) * NQKV + h * 128 + j_ * 16;
            float x[16]; unpack8(*(const u32x4*)src, x); unpack8(*(const u32x4*)(src + 8), x + 8);
            float ss = 0.f;
#pragma unroll
            for (int e = 0; e < 16; ++e) ss += x[e] * x[e];
            ss += __shfl_xor(ss, 1); ss += __shfl_xor(ss, 2); ss += __shfl_xor(ss, 4);
            const float rs = rsqrtf(ss * (1.f / 128.f) + 1e-6f) * (0.08838834764831845f * 1.4426950408889634f);
#pragma unroll
            for (int e = 0; e < 16; ++e) x[e] *= rs * g[e];
            *(LAS u32x4*)(lds + A_Q + qr * RS + j_ * 32) = pack8(x); *(LAS u32x4*)(lds + A_Q + qr * RS + j_ * 32 + 16) = pack8(x + 8);
        }
    }
    AT_STORE(0);
    __syncthreads();
    float mrun = -INFINITY, lrun = 0.f;
    f32x4 o[8];
#pragma unroll
    for (int t = 0; t < 8; ++t) o[t] = (f32x4){0.f, 0.f, 0.f, 0.f};
    bf16x8 qf[4];
#pragma unroll
    for (int ks = 0; ks < 4; ++ks) qf[ks] = *(const LAS bf16x8*)(lds + A_Q + (w * 16 + fr) * RS + (ks * 32 + fq * 8) * 2);
    const int qc = qs * 16 + fr, cs0 = min(max(qc - 8, 0), 48);
    for (int kt = 0; kt < ntiles; ++kt) {
        const bool has_next = kt + 1 < ntiles;
        if (has_next) AT_LOAD(kt + 1);
        const int kb = (kt & 1) ? A_K1 : A_K0, vb = (kt & 1) ? A_V1 : A_V0;
        const bool local = LAT && kt < nl;
        const int g = rsA + kt;
        const bool active = !local || (g >= rsw && g < rsw + 8);
        if (active) {
            f32x4 sacc[4];
#pragma unroll
            for (int k16 = 0; k16 < 4; ++k16) sacc[k16] = (f32x4){0.f, 0.f, 0.f, 0.f};
#pragma unroll
            for (int ks = 0; ks < 4; ++ks) {
                bf16x8 kf[4];
#pragma unroll
                for (int k16 = 0; k16 < 4; ++k16) kf[k16] = *(const LAS bf16x8*)(lds + kb + (k16 * 16 + fr) * RS + (ks * 32 + fq * 8) * 2);
#pragma unroll
                for (int k16 = 0; k16 < 4; ++k16) sacc[k16] = MFMA16(kf[k16], qf[ks], sacc[k16]);
            }
            if (local) {
                const volatile LAS float* rb = (const volatile LAS float*)(RPB + (g - rw + 7) * 31 + (fq * 4 - qc + 15));
                float bia[4][4];
#pragma unroll
                for (int k16 = 0; k16 < 4; ++k16)
#pragma unroll
                    for (int j = 0; j < 4; ++j) bia[k16][j] = rb[k16 * 16 + j];
#pragma unroll
                for (int k16 = 0; k16 < 4; ++k16)
#pragma unroll
                    for (int j = 0; j < 4; ++j) { const bool ok = (unsigned)(k16 * 16 + fq * 4 + j - cs0) < 16u; sacc[k16][j] = ok ? sacc[k16][j] + bia[k16][j] : -INFINITY; }
            }
            float tmax = -INFINITY;
#pragma unroll
            for (int k16 = 0; k16 < 4; ++k16)
#pragma unroll
                for (int j = 0; j < 4; ++j) tmax = fmaxf(tmax, sacc[k16][j]);
            tmax = fmaxf(tmax, __shfl_xor(tmax, 16)); tmax = fmaxf(tmax, __shfl_xor(tmax, 32));
            const float mnew = fmaxf(mrun, tmax);
            const float alpha = __builtin_amdgcn_exp2f(mrun - mnew);
            float psum = 0.f;
#pragma unroll
            for (int k16 = 0; k16 < 4; ++k16)
#pragma unroll
                for (int j = 0; j < 4; ++j) { const float pv = __builtin_amdgcn_exp2f(sacc[k16][j] - mnew); sacc[k16][j] = pv; psum += pv; }
            psum += __shfl_xor(psum, 16); psum += __shfl_xor(psum, 32);
            lrun = lrun * alpha + psum; mrun = mnew;
            float al[4];
#pragma unroll
            for (int j = 0; j < 4; ++j) al[j] = __shfl(alpha, fq * 4 + j);
            bf16x8 pa[2];
#pragma unroll
            for (int pp = 0; pp < 2; ++pp) { const u32x4 x = (u32x4){pk2(sacc[2 * pp][0], sacc[2 * pp][1]), pk2(sacc[2 * pp][2], sacc[2 * pp][3]), pk2(sacc[2 * pp + 1][0], sacc[2 * pp + 1][1]), pk2(sacc[2 * pp + 1][2], sacc[2 * pp + 1][3])}; pa[pp] = __builtin_bit_cast(bf16x8, x); }
#pragma unroll
            for (int t = 0; t < 8; ++t) {
                const int dvc = t * 16;
#pragma unroll
                for (int j = 0; j < 4; ++j) o[t][j] *= al[j];
#pragma unroll
                for (int pp = 0; pp < 2; ++pp) {
                    const s16x4 r1 = trr(lds + vb + (32 * pp + fq * 4 + tq) * RS + (dvc + 4 * tp) * 2), r2 = trr(lds + vb + (32 * pp + 16 + fq * 4 + tq) * RS + (dvc + 4 * tp) * 2);
                    o[t] = MFMA16(pa[pp], cat4(r1, r2), o[t]); }
            }
        }
        if (has_next) AT_STORE(kt + 1);
        __syncthreads();
    }
#undef AT_LOAD
#undef AT_STORE
    const float inv = 1.f / lrun;
    float iv[4];
#pragma unroll
    for (int j = 0; j < 4; ++j) iv[j] = __shfl(inv, fq * 4 + j);
#pragma unroll
    for (int t = 0; t < 8; ++t)
#pragma unroll
        for (int j = 0; j < 4; ++j) MIX[(size_t)(qrow0 + w * 16 + fq * 4 + j) * 3072 + h * 128 + t * 16 + fr] = (bf16_t)f2bf(o[t][j] * iv[j]);
}

__device__ __forceinline__ void mixer_phase(const Params& p, LAS unsigned char* lds, int l) {
    unsigned* ctr = (unsigned*)(p.ws + WS_CTR) + l;
    LAS int* nxt = (LAS int*)(lds + L_NXT);
    for (;;) {
        __syncthreads();
        if (threadIdx.x == 0) *nxt = (int)atomicAdd(ctr, 1u);
        __syncthreads();
        const int u = *nxt;
        if (u >= 2048) break;
        if (u < 256) { const int half = (u < 128) ? 1 : 0, uu = u & 127, mix = uu >> 6, rem = uu & 63, b = rem >> 4, h = (rem >> 1) & 7, dir = rem & 1;
            if (half == 0) continue;
            int z = 0; asm volatile("" : "+s"(z));
            if (mix) scan_unit<true>(p, lds, l, 1, b, h, dir, half * z, 32 + half * 32); else scan_unit<false>(p, lds, l, 1, b, h, dir, half * z, 32 + half * 32); }
        else if (u < 1280) { const int v = u - 256; attn_unit<true>(p, lds, l, v >> 8, (v >> 5) & 7, v & 31); }
        else if (u < 1792) { const int v = u - 1280, mix = v >> 8, rem = v & 255, b = rem >> 4, h = (rem >> 1) & 7, dir = rem & 1;
            if (mix) scan_unit<true>(p, lds, l, 0, b, h, dir, 0, 4); else scan_unit<false>(p, lds, l, 0, b, h, dir, 0, 4); }
        else { const int v = u - 1792; attn_unit<false>(p, lds, l, v >> 4, (v >> 1) & 7, v & 1); }
    }
}

#define XB_TMO      128
#define XB_XCNT(j)  (256  + 64 * (j))
#define XB_XSUB(j)  (1280 + 64 * (j))
#define XB_XGEN(j)  (2304 + 64 * (j))
#define XB_TOP      3328
#define XB_TOPGEN   3392
#define XCD_BAR_WORDS 3456
#define XB_SPIN_CAP (1u << 18)

__device__ __forceinline__ unsigned xb_ld(unsigned* p)              { return __hip_atomic_load(p, __ATOMIC_RELAXED, __HIP_MEMORY_SCOPE_AGENT); }
__device__ __forceinline__ unsigned xb_add(unsigned* p, unsigned v) { return __hip_atomic_fetch_add(p, v, __ATOMIC_RELAXED, __HIP_MEMORY_SCOPE_AGENT); }
__device__ __forceinline__ unsigned xb_xcc_id() { return (unsigned)__builtin_amdgcn_s_getreg((3 << 11) | 20) & 0xFu; }
#define XB_SPIN(cond, bar) do { unsigned _sp = 0; while (cond) { __builtin_amdgcn_s_sleep(1); \
    if ((++_sp & 255u) == 0u) { if (xb_ld(&(bar)[XB_TMO])) break; if (_sp > XB_SPIN_CAP) { atomicAdd(&(bar)[XB_TMO], 1u); break; } } } } while (0)

struct XcdBarrier {
    unsigned* bar; unsigned x;
    volatile LAS unsigned* st;
};

__device__ __forceinline__ XcdBarrier xcd_barrier_post(unsigned* bar, volatile LAS unsigned* st) {
    XcdBarrier b; b.bar = bar; b.x = xb_xcc_id(); b.st = st;
    if (threadIdx.x == 0) (void)xb_add(&bar[XB_XCNT(b.x)], 1u);
    return b;
}
__device__ __forceinline__ void xcd_barrier_complete(unsigned* bar, unsigned x, unsigned& nloc, unsigned& nx) {
    const unsigned G = gridDim.x * gridDim.y * gridDim.z;
    unsigned sum, cnt, mine, sp = 0u;
    for (;;) {
        sum = 0u; cnt = 0u; mine = 0u;
#pragma unroll
        for (unsigned j = 0; j < 16; ++j) { const unsigned c = xb_ld(&bar[XB_XCNT(j)]); sum += c; cnt += (c > 0u) ? 1u : 0u; mine = (j == x) ? c : mine; }
        if (sum == G) break;
        __builtin_amdgcn_s_sleep(1);
        if ((++sp & 255u) == 0u) { if (xb_ld(&bar[XB_TMO])) break; if (sp > XB_SPIN_CAP) { atomicAdd(&bar[XB_TMO], 1u); break; } }
    }
    nloc = mine > 0u ? mine : 1u; nx = cnt > 0u ? cnt : 1u;
}

__device__ __forceinline__ void xcd_barrier(const XcdBarrier& b) {
    asm volatile("s_waitcnt vmcnt(0)" ::: "memory");
    __syncthreads();
    if (threadIdx.x == 0) {
        unsigned* bar = b.bar;
        __builtin_amdgcn_s_waitcnt(0);
        unsigned nloc = b.st[0], nx = b.st[1];
        if (nloc == 0u) { xcd_barrier_complete(bar, b.x, nloc, nx); b.st[0] = nloc; b.st[1] = nx; }
        const unsigned old = xb_add(&bar[XB_XSUB(b.x)], 1u);
        const unsigned gen = old / nloc;
        if (old + 1u == (gen + 1u) * nloc) {
            __builtin_amdgcn_fence(__ATOMIC_RELEASE, "agent");
            asm volatile("s_waitcnt vmcnt(0)" ::: "memory");
            const unsigned og = xb_add(&bar[XB_TOP], 1u);
            const unsigned tg = og / nx;
            if (og + 1u == (tg + 1u) * nx) xb_add(&bar[XB_TOPGEN], 1u);
            else XB_SPIN(xb_ld(&bar[XB_TOPGEN]) == tg, bar);
            __builtin_amdgcn_fence(__ATOMIC_ACQUIRE, "agent");
            xb_add(&bar[XB_XGEN(b.x)], 1u);
            asm volatile("s_waitcnt vmcnt(0)" ::: "memory");
        } else {
            XB_SPIN(xb_ld(&bar[XB_XGEN(b.x)]) == gen, bar);
            __builtin_amdgcn_fence(__ATOMIC_ACQUIRE, "agent");
            asm volatile("s_waitcnt vmcnt(0)" ::: "memory");
        }
    }
    __syncthreads();
}

__global__ void __launch_bounds__(NTHREADS) mega(Params p) {
    extern __shared__ __attribute__((aligned(16))) unsigned char smem[];
    LAS unsigned char* lds = (LAS unsigned char*)smem;
    cg::grid_group grid = cg::this_grid();
    volatile LAS unsigned* xst = (volatile LAS unsigned*)(lds + 131072 + 64);
    if (threadIdx.x < 2) xst[threadIdx.x] = 0u;
    __syncthreads();
    const XcdBarrier xbar = xcd_barrier_post((unsigned*)(p.ws + WS_BAR), xst);
    unsigned char* ws = p.ws;
    const int G = gridDim.x, c = blockIdx.x;
    bf16_t* H = (bf16_t*)(ws + WS_R1);
    bf16_t* QKV = (bf16_t*)(ws + WS_R2);
    bf16_t* GATES = (bf16_t*)(ws + WS_R3);
    bf16_t* MIX = (bf16_t*)(ws + WS_R4);
    float* X = p.out;

    p0_misc(p, lds);
    __syncthreads();
    conv_layer(p, 0, lds);
    if (p.ws == nullptr) grid.sync();
    xcd_barrier(xbar);
    for (int l = 0; l < 2; ++l) {
        const float* mod = (const float*)(ws + WS_MOD) + (size_t)l * 5 * 12288;
        const float* xa = l == 0 ? p.in[0] : X; const float* xb = l == 0 ? p.in[1] : X + (size_t)MCTX * D;
        if (l > 0) conv_layer(p, l, lds);
        norm_mod_phase(xa, xb, p.in[12] + l * D, mod, 0, 2048, H, l > 0 ? (const float*)(ws + WS_R3) : nullptr, X);
        xcd_barrier(xbar);
        { pg8::Gemm g{H, (const bf16_t*)(ws + WS_R4), MROWS, NPROJ, D, D, 0}; pg8::StaticOrder S; S.init(MROWS, NPROJ, D, G, c);
          EpiProj E{QKV, GATES, (float*)(ws + WS_MGATE)}; pg8::gemm_phase(lds, g, S, E); }
        xcd_barrier(xbar);
        mixer_phase(p, lds, l);
        xcd_barrier(xbar);
        finalize_phase((const bf16_t*)(ws + WS_R1), QKV, p.in[20] + l * 1024, p.in[21] + l * 1024, MIX);
        xcd_barrier(xbar);
        { pg8::Gemm g{MIX, (const bf16_t*)(ws + WS_WBR), MROWS, D, 1024, 3072, 1024}; pg8::BranchOrder S; S.init(MROWS, D, 1024, G, c);
          EpiBranch E{GATES, (bf16_t*)(ws + WS_R1), QKV}; pg8::gemm_phase(lds, g, S, E); }
        xcd_barrier(xbar);
        { pg8::Gemm g{QKV, (const bf16_t*)(ws + WS_WOUT3), MROWS, D, D, D, 0}; pg8::StaticOrder S; S.init(MROWS, D, D, G, c);
          EpiResid E{xa, xb, X, mod, 4096}; pg8::gemm_phase(lds, g, S, E); }
        xcd_barrier(xbar);
        norm_mod_phase(X, X + (size_t)MCTX * D, p.in[13] + l * D, mod, 6144, 8192, H, nullptr, nullptr);
        xcd_barrier(xbar);
        { pg8::Gemm g{H, (const bf16_t*)(ws + WS_FF1), MROWS, FFD, D, D, 0}; pg8::StaticOrder S; S.init(MROWS, FFD, D, G, c);
          EpiRelu2 E{QKV}; pg8::gemm_phase(lds, g, S, E); }
        xcd_barrier(xbar);
        { pg8::Gemm g{QKV, (const bf16_t*)(ws + WS_FF2), MROWS, D, FFD, FFD, 0}; pg8::SplitTailOrder S; S.init(MROWS, D, FFD, 64, G, c);
          EpiResidSplit E{X, (float*)(ws + WS_R3), mod, 10240}; pg8::gemm_phase(lds, g, S, E); }
        xcd_barrier(xbar);
    }
    { const int tid = otid(); const float* f0 = (const float*)(ws + WS_R3); const float* f1 = f0 + (size_t)4096 * D; float* xo = X + (size_t)16384 * D;
      for (int i = blockIdx.x * NTHREADS + tid; i < 4096 * D / 4; i += gridDim.x * NTHREADS) { f32x4 v = ((const f32x4*)xo)[i]; v += ((const f32x4*)f0)[i] + ((const f32x4*)f1)[i]; ((f32x4*)xo)[i] = v; } }
}

extern "C" void kernel_launch(void* const* d_in, const int* in_sizes, int n_in, void* d_out, int out_size, void* d_ws, size_t ws_size, hipStream_t stream) {
    static int grid = 0;
    if (grid == 0) {
        if (n_in != 28 || ws_size < WS_END) { fprintf(stderr, "kernel_launch: unexpected inputs (n_in %d, ws %zu < %zu)\n", n_in, ws_size, (size_t)WS_END); grid = -1; return; }
        int dev = 0, cus = 0, per_cu = 0;
        hipGetDevice(&dev);
        hipDeviceGetAttribute(&cus, hipDeviceAttributeMultiprocessorCount, dev);
        hipFuncSetAttribute((const void*)mega, hipFuncAttributeMaxDynamicSharedMemorySize, LDS_BYTES);
        hipOccupancyMaxActiveBlocksPerMultiprocessor(&per_cu, (const void*)mega, NTHREADS, LDS_BYTES);
        if (per_cu < 1) per_cu = 1;
        grid = cus * per_cu;
        (void)hipGetLastError();
    }
    if (grid < 0) return;
    if (hipMemsetAsync((char*)d_ws + WS_CTR, 0, WS_END - WS_CTR, stream) != hipSuccess) { fprintf(stderr, "memset failed\n"); return; }
    if (hipMemsetAsync((char*)d_ws + WS_MOD, 0, 2ull * 5 * 12288 * 4, stream) != hipSuccess) { fprintf(stderr, "memset failed\n"); return; }
    Params p{};
    for (int i = 0; i < 28; ++i) p.in[i] = (const float*)d_in[i];
    p.out = (float*)d_out; p.ws = (unsigned char*)d_ws;
    void* args[] = {&p};
    hipError_t e = hipLaunchCooperativeKernel((const void*)mega, dim3(grid), dim3(NTHREADS), args, LDS_BYTES, stream);
    if (e != hipSuccess) fprintf(stderr, "cooperative launch failed: %s (grid %d)\n", hipGetErrorString(e), grid);
}
```

```cpp
#include <hip/hip_runtime.h>
#include <hip/hip_cooperative_groups.h>
#include <cstdio>
#include <cstdint>
namespace cg = cooperative_groups;

#define LAS __attribute__((address_space(3)))
typedef unsigned short bf16_t;
typedef short bf16x8 __attribute__((ext_vector_type(8)));
typedef short s16x4 __attribute__((ext_vector_type(4)));
typedef short v4i16_t __attribute__((ext_vector_type(4)));
typedef float f32x4 __attribute__((ext_vector_type(4)));
typedef unsigned u32x4 __attribute__((ext_vector_type(4)));
typedef unsigned u32x2 __attribute__((ext_vector_type(2)));

constexpr int D = 2048, MROWS = 20480, MCTX = 4096;
constexpr int NQKV = 11264, NGATE = 6144, NPROJ = 17664, FFD = 8192;
constexpr int NTHREADS = 512;
constexpr int LDS_BYTES = 135168;

constexpr size_t WS_WBR   = 0;
constexpr size_t WS_WOUT3 = WS_WBR + 6144ull * 1024 * 2;
constexpr size_t WS_FF1   = WS_WOUT3 + 2048ull * 6144 * 2;
constexpr size_t WS_FF2   = WS_FF1 + 8192ull * 2048 * 2;
constexpr size_t WS_R1    = WS_FF2 + 2048ull * 8192 * 2;
constexpr size_t WS_R2    = WS_R1 + (size_t)MROWS * 1024 * 2 * 4;
constexpr size_t WS_R3    = WS_R2 + (size_t)MROWS * NQKV * 2;
constexpr size_t WS_R4    = WS_R3 + (size_t)MROWS * NGATE * 2;
constexpr size_t WS_MGATE = WS_R4 + (size_t)MROWS * 3072 * 2;
constexpr size_t WS_MOD   = WS_MGATE + (size_t)MROWS * 32 * 4;
constexpr size_t WS_ROPE  = WS_MOD + 2ull * 5 * 12288 * 4;
constexpr size_t WS_CK    = WS_ROPE + 2ull * 2048 * 4;
constexpr size_t WS_CV    = WS_CK + 4ull * 2 * 512 * 1024 * 2;
constexpr size_t WS_CTR   = WS_CV + 4ull * 2 * 512 * 1024 * 2;
constexpr size_t WS_BAR   = WS_CTR + 256;
constexpr size_t WS_END   = WS_BAR + 16128;

constexpr size_t OUT_NAK = 41943040, OUT_NAV = 50331648, OUT_RET = 58720256, OUT_MC = 67108864, OUT_MN = 75497472, OUT_MM = 75563008;

struct Params { const float* in[28]; float* out; unsigned char* ws; };

__device__ __forceinline__ int otid() { int t = threadIdx.x; asm volatile("" : "+v"(t)); return t; }
__device__ __forceinline__ unsigned pk2(float lo, float hi) { unsigned r; asm("v_cvt_pk_bf16_f32 %0, %1, %2" : "=v"(r) : "v"(lo), "v"(hi)); return r; }
__device__ __forceinline__ unsigned f2bf(float f) { return pk2(f, f) & 0xffffu; }
__device__ __forceinline__ float bflo(unsigned w) { return __builtin_bit_cast(float, w << 16); }
__device__ __forceinline__ float bfhi(unsigned w) { return __builtin_bit_cast(float, w & 0xffff0000u); }
__device__ __forceinline__ float bf2f(unsigned short h) { return __builtin_bit_cast(float, (unsigned)h << 16); }
__device__ __forceinline__ float sigm(float x) { return __builtin_amdgcn_rcpf(1.f + __builtin_amdgcn_exp2f(x * -1.4426950408889634f)); }
__device__ __forceinline__ void unpack8(const u32x4 w, float* f) {
    f[0] = bflo(w.x); f[1] = bfhi(w.x); f[2] = bflo(w.y); f[3] = bfhi(w.y); f[4] = bflo(w.z); f[5] = bfhi(w.z); f[6] = bflo(w.w); f[7] = bfhi(w.w);
}
__device__ __forceinline__ u32x4 pack8(const float* f) { u32x4 w; w.x = pk2(f[0], f[1]); w.y = pk2(f[2], f[3]); w.z = pk2(f[4], f[5]); w.w = pk2(f[6], f[7]); return w; }
__device__ __forceinline__ s16x4 trr(LAS const unsigned char* p) { return __builtin_bit_cast(s16x4, __builtin_amdgcn_ds_read_tr16_b64_v4i16((LAS v4i16_t*)p)); }
__device__ __forceinline__ bf16x8 cat4(s16x4 a, s16x4 b) { bf16x8 r; r[0] = a[0]; r[1] = a[1]; r[2] = a[2]; r[3] = a[3]; r[4] = b[0]; r[5] = b[1]; r[6] = b[2]; r[7] = b[3]; return r; }

namespace pg8 {
constexpr int BM = 256, BK = 64, HALF = 128, HTB = HALF * BK * 2, STAGE_BYTES = 8 * HTB, NXCD = 8, WGM = 8;
__host__ __device__ __forceinline__ int lds_byte(int r, int c) { const int st = (r >> 4) * 2 + (c >> 5), rr = r & 15, cc = c & 31, ob = rr * 64 + cc * 2; return st * 1024 + (ob ^ (((ob >> 9) & 1) << 5)); }
__host__ __device__ __forceinline__ void stage_rc(int b, int& R, int& C) { const int st = b / 1024, sb = b % 1024, swz = sb ^ (((sb >> 9) & 1) << 5); R = (st >> 1) * 16 + swz / 64; C = (st & 1) * 32 + (swz % 64) / 2; }
__host__ __device__ __forceinline__ int perm32(int rho) { const int n = rho >> 4, i = rho & 15; return 8 * (i >> 2) + 4 * n + (i & 3); }
struct Unit { int pm, pn, ab, bn, k0, nt; };
struct Gemm { const bf16_t* A; const bf16_t* Bt; int M, N, K, lda, acs; };
struct StaticOrder {
    int nM, nN, nwg, G, c, ntk;
    __device__ void init(int M, int N, int K, int G_, int c_) { nM = M / BM; nN = N / BM; nwg = nM * nN; G = G_; c = c_; ntk = K / BK; }
    __device__ bool next(int i, Unit& u) const {
        const long L = (long)i * G + c; if (L >= nwg) return false;
        int wgid = (int)L; { const int q = nwg / NXCD, r = nwg % NXCD, xcd = wgid % NXCD, off = wgid / NXCD; wgid = (xcd < r ? xcd * (q + 1) : r * (q + 1) + (xcd - r) * q) + off; }
        const int nig = WGM * nN, gid = wgid / nig, fm = gid * WGM, gsz = (nM - fm) < WGM ? (nM - fm) : WGM;
        u.pm = fm + ((wgid % nig) % gsz); u.pn = (wgid % nig) / gsz; u.ab = 0; u.bn = u.pn; u.k0 = 0; u.nt = ntk; return true;
    }
};
struct BranchOrder {
    int nM, nN, nwg, G, c, ntk;
    __device__ void init(int M, int N, int K, int G_, int c_) { nM = M / BM; nN = N / BM; nwg = nM * nN; G = G_; c = c_; ntk = K / BK; }
    __device__ bool next(int i, Unit& u) const {
        const int br = i % 3; const long L = (long)(i / 3) * G + c; if (L >= nwg) return false;
        int wgid = (int)L; { const int q = nwg / NXCD, r = nwg % NXCD, xcd = wgid % NXCD, off = wgid / NXCD; wgid = (xcd < r ? xcd * (q + 1) : r * (q + 1) + (xcd - r) * q) + off; }
        const int nig = WGM * nN, gid = wgid / nig, fm = gid * WGM, gsz = (nM - fm) < WGM ? (nM - fm) : WGM;
        u.pm = fm + ((wgid % nig) % gsz); u.pn = (wgid % nig) / gsz; u.ab = br; u.bn = br * nN + u.pn; u.k0 = 0; u.nt = ntk; return true;
    }
};

struct SplitTailOrder {
    int nM, nN, nMf, nfull, G, c, ntk;
    __device__ void init(int M, int N, int K, int nMf_, int G_, int c_) { nM = M / BM; nN = N / BM; nMf = nMf_; nfull = nMf * nN; G = G_; c = c_; ntk = K / BK; }
    __device__ bool next(int i, Unit& u) const {
        const long L = (long)i * G + c;
        if (L < nfull) {
            int wgid = (int)L; { const int q = nfull / NXCD, r = nfull % NXCD, xcd = wgid % NXCD, off = wgid / NXCD; wgid = (xcd < r ? xcd * (q + 1) : r * (q + 1) + (xcd - r) * q) + off; }
            const int nig = WGM * nN, gid = wgid / nig, fm = gid * WGM, gsz = (nMf - fm) < WGM ? (nMf - fm) : WGM;
            u.pm = fm + ((wgid % nig) % gsz); u.pn = (wgid % nig) / gsz; u.ab = 0; u.bn = u.pn; u.k0 = 0; u.nt = ntk; return true;
        }
        const long hL = L - nfull; if (hL >= 2L * (nM - nMf) * nN) return false;
        const int half = (int)(hL & 1), tt = (int)(hL >> 1);
        u.pm = nMf + tt / nN; u.pn = tt % nN; u.ab = 1 + half; u.bn = u.pn; u.k0 = half * (ntk / 2) * BK; u.nt = ntk / 2; return true;
    }
};

template <class Epi, class Sched>
__device__ __forceinline__ void gemm_phase(LAS unsigned char* lds, const Gemm g, const Sched& S, const Epi& E) {
    const int tid = otid(), wid = __builtin_amdgcn_readfirstlane(tid >> 6), lane = tid & 63, wr = wid >> 2, wc = wid & 3, fr = lane & 15, fq = lane >> 4;
    const int K = g.K;
    const char* gA = (const char*)g.A; const char* gB = (const char*)g.Bt;
    asm volatile("" : "+s"(gA), "+s"(gB));
    unsigned voffA[2], voffB[2];
#pragma unroll
    for (int i = 0; i < 2; ++i) { int R, C; stage_rc(tid * 16 + i * 8192, R, C); const int Rb = (R & ~31) + perm32(R & 31);
        voffA[i] = (unsigned)(R * g.lda + C) * 2u; voffB[i] = (unsigned)(Rb * K + C) * 2u; }
    const size_t kstep = (size_t)(BK * 2);
    const size_t hstepA = (size_t)HALF * g.lda * 2, hstepB = (size_t)HALF * K * 2;
    const size_t tstepA = 2 * hstepA, tstepB = 2 * hstepB;
    const unsigned ldsw = (unsigned)wid * 1024u;
    const int aoff = lds_byte(wr * 64 + fr, fq * 8), boff = lds_byte(wc * 32 + fr, fq * 8);
#define PG8_SA(b, h) (((b) * 2 + (h)) * HTB)
#define PG8_SB(b, h) ((4 + (b) * 2 + (h)) * HTB)
#define PG8_STAGE(bufoff, gbase, voff) do { _Pragma("unroll") for (int _i = 0; _i < 2; ++_i) \
        __builtin_amdgcn_global_load_lds((const unsigned*)((const char*)(gbase) + (voff)[_i]), (LAS unsigned*)(lds + (bufoff) + ldsw + _i * 8192), 16, 0, 0); } while (0)
#define PG8_LDA(dst, b, h) do { _Pragma("unroll") for (int m = 0; m < 4; ++m) _Pragma("unroll") for (int k = 0; k < 2; ++k) dst[m][k] = *(const LAS bf16x8*)(lds + PG8_SA(b, h) + aoff + m * 2048 + k * 1024); } while (0)
#define PG8_LDB(dst, b, h) do { _Pragma("unroll") for (int n = 0; n < 2; ++n) _Pragma("unroll") for (int k = 0; k < 2; ++k) dst[n][k] = *(const LAS bf16x8*)(lds + PG8_SB(b, h) + boff + n * 2048 + k * 1024); } while (0)
#define PG8_MMA(ai, bj, At, Bt) do { __builtin_amdgcn_s_setprio(1); _Pragma("unroll") for (int m = 0; m < 4; ++m) _Pragma("unroll") for (int n = 0; n < 2; ++n) _Pragma("unroll") for (int k = 0; k < 2; ++k) \
        acc[ai][bj][m][n] = __builtin_amdgcn_mfma_f32_16x16x32_bf16(Bt[n][k], At[m][k], acc[ai][bj][m][n], 0, 0, 0); __builtin_amdgcn_s_setprio(0); } while (0)
#define PG8_WAIT_V(n) asm volatile("s_waitcnt vmcnt(" #n ")" ::: "memory")
#define PG8_WAIT_L(n) asm volatile("s_waitcnt lgkmcnt(" #n ")" ::: "memory")
#define PG8_BAR __builtin_amdgcn_s_barrier()
#define PG8_SCHED __builtin_amdgcn_sched_barrier(0)
    Unit cur, nxt; int ui = 0;
    if (!S.next(0, cur)) return;
    f32x4 acc[2][2][4][2];
#pragma unroll
    for (int a = 0; a < 2; ++a)
#pragma unroll
        for (int b = 0; b < 2; ++b)
#pragma unroll
            for (int m = 0; m < 4; ++m)
#pragma unroll
                for (int n = 0; n < 2; ++n) acc[a][b][m][n] = (f32x4){0.f, 0.f, 0.f, 0.f};
    bf16x8 At[4][2], B0[2][2], B1[2][2];
    const char* cA = gA + (size_t)cur.pm * tstepA + (size_t)cur.ab * g.acs * 2 + (size_t)cur.k0 * 2; const char* cB = gB + (size_t)cur.bn * tstepB + (size_t)cur.k0 * 2;
    PG8_STAGE(PG8_SB(0, 0), cB, voffB); PG8_STAGE(PG8_SB(0, 1), cB + hstepB, voffB); PG8_STAGE(PG8_SA(0, 0), cA, voffA); PG8_STAGE(PG8_SA(0, 1), cA + hstepA, voffA);
    if (wr == 1) PG8_BAR;
    PG8_WAIT_V(2); PG8_BAR;
    PG8_STAGE(PG8_SB(1, 0), cB + kstep, voffB); PG8_STAGE(PG8_SA(1, 0), cA + kstep, voffA); PG8_STAGE(PG8_SB(1, 1), cB + hstepB + kstep, voffB);
    PG8_WAIT_V(6); PG8_BAR;
    for (;;) {
        const bool has_next = S.next(ui + 1, nxt);
        const char* nA = has_next ? gA + (size_t)nxt.pm * tstepA + (size_t)nxt.ab * g.acs * 2 + (size_t)nxt.k0 * 2 : cA; const char* nB = has_next ? gB + (size_t)nxt.bn * tstepB + (size_t)nxt.k0 * 2 : cB;
        const int nt = cur.nt;
        for (int t = 0; t < nt; t += 2) {
            const bool last = (t == nt - 2);
            const char* a1 = cA + (size_t)(t + 1) * kstep;
            const char* a2 = last ? nA : cA + (size_t)(t + 2) * kstep; const char* b2 = last ? nB : cB + (size_t)(t + 2) * kstep;
            const char* a3 = a2 + kstep; const char* b3 = b2 + kstep;
            PG8_LDB(B0, 0, 0); PG8_LDB(B1, 0, 1); PG8_SCHED; PG8_LDA(At, 0, 0); PG8_STAGE(PG8_SA(1, 1), a1 + hstepA, voffA);
            PG8_WAIT_V(8); PG8_WAIT_L(0); PG8_BAR; PG8_MMA(0, 0, At, B0); PG8_MMA(0, 1, At, B1); PG8_BAR; PG8_SCHED;
            PG8_LDA(At, 0, 1); PG8_STAGE(PG8_SB(0, 0), b2, voffB); PG8_STAGE(PG8_SB(0, 1), b2 + hstepB, voffB); PG8_STAGE(PG8_SA(0, 0), a2, voffA);
            PG8_WAIT_V(8); PG8_WAIT_L(0); PG8_BAR; PG8_MMA(1, 0, At, B0); PG8_MMA(1, 1, At, B1); PG8_BAR; PG8_SCHED;
            PG8_LDB(B0, 1, 0); PG8_LDB(B1, 1, 1); PG8_SCHED; PG8_LDA(At, 1, 0); PG8_STAGE(PG8_SA(0, 1), a2 + hstepA, voffA);
            PG8_WAIT_V(8); PG8_WAIT_L(0); PG8_BAR; PG8_MMA(0, 0, At, B0); PG8_MMA(0, 1, At, B1); PG8_BAR; PG8_SCHED;
            PG8_LDA(At, 1, 1); PG8_STAGE(PG8_SB(1, 0), b3, voffB); PG8_STAGE(PG8_SB(1, 1), b3 + hstepB, voffB); PG8_STAGE(PG8_SA(1, 0), a3, voffA);
            PG8_WAIT_V(8); PG8_WAIT_L(0); PG8_BAR; PG8_MMA(1, 0, At, B0); PG8_MMA(1, 1, At, B1); PG8_BAR; PG8_SCHED;
        }
        if (wr == 0) PG8_BAR;
        E(acc, cur, wr, wc, fr, fq);
        if (!has_next) break;
#pragma unroll
        for (int a = 0; a < 2; ++a)
#pragma unroll
            for (int b = 0; b < 2; ++b)
#pragma unroll
                for (int m = 0; m < 4; ++m)
#pragma unroll
                    for (int n = 0; n < 2; ++n) acc[a][b][m][n] = (f32x4){0.f, 0.f, 0.f, 0.f};
        cur = nxt; cA = nA; cB = nB; ++ui;
        if (wr == 1) PG8_BAR;
    }
    PG8_WAIT_V(0);
    PG8_BAR;
#undef PG8_SA
#undef PG8_SB
#undef PG8_STAGE
#undef PG8_LDA
#undef PG8_LDB
#undef PG8_MMA
#undef PG8_WAIT_V
#undef PG8_WAIT_L
#undef PG8_BAR
#undef PG8_SCHED
}
}

struct EpiProj {
    bf16_t* qkv; bf16_t* gates; float* mgate;
    __device__ __forceinline__ void operator()(const f32x4 (&acc)[2][2][4][2], const pg8::Unit& u, int wr, int wc, int fr, int fq) const {
        const int row0 = u.pm * 256 + wr * 64 + fr;
        if (u.pn < 68) {
            bf16_t* base; int ldc, colt;
            if (u.pn < 44) { base = qkv; ldc = NQKV; colt = u.pn * 256; } else { base = gates; ldc = NGATE; colt = (u.pn - 44) * 256; }
            const int col0 = colt + wc * 32 + 8 * fq;
#pragma unroll
            for (int ai = 0; ai < 2; ++ai)
#pragma unroll
                for (int m = 0; m < 4; ++m) { bf16_t* rowp = base + (size_t)(row0 + ai * 128 + m * 16) * ldc + col0;
#pragma unroll
                    for (int bj = 0; bj < 2; ++bj) { const f32x4 v0 = acc[ai][bj][m][0], v1 = acc[ai][bj][m][1];
                        u32x4 w; w.x = pk2(v0[0], v0[1]); w.y = pk2(v0[2], v0[3]); w.z = pk2(v1[0], v1[1]); w.w = pk2(v1[2], v1[3]);
                        *(u32x4*)(rowp + bj * 128) = w; } }
        } else if (wc == 0) {
#pragma unroll
            for (int ai = 0; ai < 2; ++ai)
#pragma unroll
                for (int m = 0; m < 4; ++m) { float* rowp = mgate + (size_t)(row0 + ai * 128 + m * 16) * 32 + 8 * fq;
                    *(f32x4*)rowp = acc[ai][0][m][0]; *(f32x4*)(rowp + 4) = acc[ai][0][m][1]; }
        }
    }
};
struct EpiBranch {
    const bf16_t* gates; bf16_t* tmp; bf16_t* mixed;
    __device__ __forceinline__ void operator()(const f32x4 (&acc)[2][2][4][2], const pg8::Unit& u, int wr, int wc, int fr, int fq) const {
        const int row0 = u.pm * 256 + wr * 64 + fr, col0 = u.pn * 256 + wc * 32 + 8 * fq, br = u.ab;
        bf16_t* dstb = (br < 2) ? tmp : mixed;
#pragma unroll
        for (int ai = 0; ai < 2; ++ai)
#pragma unroll
            for (int m = 0; m < 4; ++m) { const size_t row = (size_t)(row0 + ai * 128 + m * 16);
#pragma unroll
                for (int bj = 0; bj < 2; ++bj) { f32x4 v0 = acc[ai][bj][m][0], v1 = acc[ai][bj][m][1];
                    const u32x4 gw = *(const u32x4*)(gates + row * NGATE + br * D + col0 + bj * 128); float gf[8]; unpack8(gw, gf);
#pragma unroll
                    for (int e = 0; e < 4; ++e) { v0[e] *= sigm(gf[e]); v1[e] *= sigm(gf[4 + e]); }
                    const size_t eo = row * D + col0 + bj * 128;
                    if (br > 0) { float pf[8]; unpack8(*(const u32x4*)(tmp + eo), pf);
#pragma unroll
                        for (int e = 0; e < 4; ++e) { v0[e] += pf[e]; v1[e] += pf[4 + e]; } }
                    u32x4 w; w.x = pk2(v0[0], v0[1]); w.y = pk2(v0[2], v0[3]); w.z = pk2(v1[0], v1[1]); w.w = pk2(v1[2], v1[3]);
                    *(u32x4*)(dstb + eo) = w; } }
    }
};
struct EpiResid {
    const float* xa; const float* xb; float* xo; const float* mod; int goff;
    __device__ __forceinline__ void operator()(const f32x4 (&acc)[2][2][4][2], const pg8::Unit& u, int wr, int wc, int fr, int fq) const {
        const int row0 = u.pm * 256 + wr * 64 + fr, col0 = u.pn * 256 + wc * 32 + 8 * fq;
        const int mr = (u.pm < 16) ? 0 : 1 + ((u.pm - 16) >> 4);
        const float* gp_ = mod + (size_t)mr * 12288 + goff + col0;
        f32x4 g[2][2];
#pragma unroll
        for (int bj = 0; bj < 2; ++bj) { g[bj][0] = *(const f32x4*)(gp_ + bj * 128); g[bj][1] = *(const f32x4*)(gp_ + bj * 128 + 4); }
#pragma unroll
        for (int ai = 0; ai < 2; ++ai)
#pragma unroll
            for (int m = 0; m < 4; ++m) { const int row = row0 + ai * 128 + m * 16;
                const float* xi = (row < MCTX ? xa + (size_t)row * D : xb + (size_t)(row - MCTX) * D) + col0; float* xw = xo + (size_t)row * D + col0;
#pragma unroll
                for (int bj = 0; bj < 2; ++bj) { const f32x4 x0 = *(const f32x4*)(xi + bj * 128), x1 = *(const f32x4*)(xi + bj * 128 + 4);
                    *(f32x4*)(xw + bj * 128) = x0 + g[bj][0] * acc[ai][bj][m][0]; *(f32x4*)(xw + bj * 128 + 4) = x1 + g[bj][1] * acc[ai][bj][m][1]; } }
    }
};
struct EpiResidSplit {
    float* x; float* part; const float* mod; int goff;
    __device__ __forceinline__ void operator()(const f32x4 (&acc)[2][2][4][2], const pg8::Unit& u, int wr, int wc, int fr, int fq) const {
        const int row0 = u.pm * 256 + wr * 64 + fr, col0 = u.pn * 256 + wc * 32 + 8 * fq;
        const int mr = (u.pm < 16) ? 0 : 1 + ((u.pm - 16) >> 4);
        const float* gp_ = mod + (size_t)mr * 12288 + goff + col0;
        f32x4 g[2][2];
#pragma unroll
        for (int bj = 0; bj < 2; ++bj) { g[bj][0] = *(const f32x4*)(gp_ + bj * 128); g[bj][1] = *(const f32x4*)(gp_ + bj * 128 + 4); }
        const bool full = (u.ab == 0);
        float* base = full ? x : part + (size_t)(u.ab - 1) * 4096 * D - (size_t)16384 * D;
#pragma unroll
        for (int ai = 0; ai < 2; ++ai)
#pragma unroll
            for (int m = 0; m < 4; ++m) { const int row = row0 + ai * 128 + m * 16; float* xw = base + (size_t)row * D + col0;
#pragma unroll
                for (int bj = 0; bj < 2; ++bj) { f32x4 v0 = g[bj][0] * acc[ai][bj][m][0], v1 = g[bj][1] * acc[ai][bj][m][1];
                    if (full) { v0 += *(const f32x4*)(xw + bj * 128); v1 += *(const f32x4*)(xw + bj * 128 + 4); }
                    *(f32x4*)(xw + bj * 128) = v0; *(f32x4*)(xw + bj * 128 + 4) = v1; } }
    }
};
struct EpiRelu2 {
    bf16_t* o;
    __device__ __forceinline__ void operator()(const f32x4 (&acc)[2][2][4][2], const pg8::Unit& u, int wr, int wc, int fr, int fq) const {
        const int row0 = u.pm * 256 + wr * 64 + fr, col0 = u.pn * 256 + wc * 32 + 8 * fq;
#pragma unroll
        for (int ai = 0; ai < 2; ++ai)
#pragma unroll
            for (int m = 0; m < 4; ++m) { bf16_t* rowp = o + (size_t)(row0 + ai * 128 + m * 16) * FFD + col0;
#pragma unroll
                for (int bj = 0; bj < 2; ++bj) { f32x4 v0 = acc[ai][bj][m][0], v1 = acc[ai][bj][m][1];
#pragma unroll
                    for (int e = 0; e < 4; ++e) { v0[e] = fmaxf(v0[e], 0.f); v0[e] *= v0[e]; v1[e] = fmaxf(v1[e], 0.f); v1[e] *= v1[e]; }
                    u32x4 w; w.x = pk2(v0[0], v0[1]); w.y = pk2(v0[2], v0[3]); w.z = pk2(v1[0], v1[1]); w.w = pk2(v1[2], v1[3]);
                    *(u32x4*)(rowp + bj * 128) = w; } }
    }
};

__device__ __forceinline__ void conv_mat(const float* __restrict__ W, int ldw, int K, int n0, int ncols, bf16_t* WT, int ldt, int row0, int col0, LAS float* tile) {
    const int tid = otid();
    const int ntk = K / 64, nt = (ncols / 64) * ntk;
    for (int t = blockIdx.x; t < nt; t += gridDim.x) {
        const int tk = t % ntk, tn = t / ntk;
        const int kk = tid >> 4, n4 = (tid & 15) * 4;
#pragma unroll
        for (int h = 0; h < 2; ++h) {
            const int k = tk * 64 + kk + h * 32;
            const f32x4 v = *(const f32x4*)(W + (size_t)k * ldw + n0 + tn * 64 + n4);
            tile[(n4 + 0) * 65 + kk + h * 32] = v[0]; tile[(n4 + 1) * 65 + kk + h * 32] = v[1]; tile[(n4 + 2) * 65 + kk + h * 32] = v[2]; tile[(n4 + 3) * 65 + kk + h * 32] = v[3];
        }
        __syncthreads();
        const int nl = tid >> 3, k8 = (tid & 7) * 8;
        float f[8];
#pragma unroll
        for (int j = 0; j < 8; ++j) f[j] = tile[nl * 65 + k8 + j];
        *(u32x4*)(WT + (size_t)(row0 + tn * 64 + nl) * ldt + col0 + tk * 64 + k8) = pack8(f);
        __syncthreads();
    }
}
__device__ __forceinline__ void conv_layer(const Params& p, int l, LAS unsigned char* lds) {
    LAS float* tile = (LAS float*)lds;
    unsigned char* ws = p.ws;
    bf16_t* WinT = (bf16_t*)(ws + WS_R4);
    const float* w_in = p.in[14] + (size_t)l * D * 17440;
    conv_mat(w_in, 17440, D, 0, 11264, WinT, D, 0, 0, tile);
    conv_mat(w_in, 17440, D, 11296, 6144, WinT, D, 11264, 0, tile);
    for (int i = blockIdx.x * NTHREADS + threadIdx.x; i < 32 * D; i += gridDim.x * NTHREADS) { const int n = i >> 11, k = i & 2047; WinT[(size_t)(17408 + n) * D + k] = (bf16_t)f2bf(w_in[(size_t)k * 17440 + 11264 + n]); }
    bf16_t* wbr = (bf16_t*)(ws + WS_WBR);
    for (int br = 0; br < 3; ++br) conv_mat(p.in[22 + br] + (size_t)l * 1024 * D, D, 1024, 0, D, wbr, 1024, br * D, 0, tile);
    conv_mat(p.in[25] + (size_t)l * D * D, D, D, 0, D, (bf16_t*)(ws + WS_WOUT3), D, 0, 0, tile);
    conv_mat(p.in[26] + (size_t)l * D * FFD, FFD, D, 0, FFD, (bf16_t*)(ws + WS_FF1), D, 0, 0, tile);
    conv_mat(p.in[27] + (size_t)l * FFD * D, D, FFD, 0, D, (bf16_t*)(ws + WS_FF2), FFD, 0, 0, tile);
}

__device__ __forceinline__ void p0_misc(const Params& p, LAS unsigned char* lds) {
    const int tid = otid();
    unsigned char* ws = p.ws;
    LAS float* sc = (LAS float*)lds;
    LAS float* red = (LAS float*)(lds + 40960);
    for (int i = tid; i < 5 * D; i += NTHREADS) { const int r = i >> 11, k = i & 2047; const float v = (r == 0) ? p.in[9][k] : p.in[2][(r - 1) * D + k]; sc[i] = v / (1.f + __expf(-v)); }
    __syncthreads();
    float* MOD = (float*)(ws + WS_MOD);
    for (int item = blockIdx.x; item < 768; item += gridDim.x) {
        const int kh = item & 1, it2 = item >> 1, l = it2 / 192, cb = it2 % 192, cl = tid & 63, kg = tid >> 6;
        const int kbase = kh * 1024 + kg * 128;
        const float* w = p.in[10] + (size_t)l * D * 12288 + (size_t)kbase * 12288 + cb * 64 + cl;
        float a0 = 0.f, a1 = 0.f, a2 = 0.f, a3 = 0.f, a4 = 0.f;
#pragma unroll 1
        for (int i0 = 0; i0 < 128; i0 += 32) {
            float wv[32];
#pragma unroll
            for (int i = 0; i < 32; ++i) wv[i] = w[(size_t)(i0 + i) * 12288];
#pragma unroll
            for (int i = 0; i < 32; ++i) { const int k = kbase + i0 + i;
                a0 += sc[k] * wv[i]; a1 += sc[D + k] * wv[i]; a2 += sc[2 * D + k] * wv[i]; a3 += sc[3 * D + k] * wv[i]; a4 += sc[4 * D + k] * wv[i]; }
        }
        red[(kg * 5 + 0) * 64 + cl] = a0; red[(kg * 5 + 1) * 64 + cl] = a1; red[(kg * 5 + 2) * 64 + cl] = a2; red[(kg * 5 + 3) * 64 + cl] = a3; red[(kg * 5 + 4) * 64 + cl] = a4;
        __syncthreads();
        if (tid < 320) { const int r = tid >> 6; float s = 0.f;
#pragma unroll
            for (int g = 0; g < 8; ++g) s += red[(g * 5 + r) * 64 + cl];
            if (kh == 0) s += p.in[11][l * 12288 + cb * 64 + cl];
            atomicAdd(&MOD[(size_t)(l * 5 + r) * 12288 + cb * 64 + cl], s); }
        __syncthreads();
    }
    { const int i = blockIdx.x * NTHREADS + tid; if (i < 2048) { const int pos = i >> 5, fi = i & 31; const float inv = expf(-(float)fi * (9.210340371976184f / 32.f)); const float ang = (float)pos * inv;
        float* rp = (float*)(ws + WS_ROPE); rp[i] = cosf(ang); rp[2048 + i] = sinf(ang); } }
    { u32x2* ck = (u32x2*)(ws + WS_CK); u32x2* cv = (u32x2*)(ws + WS_CV); const f32x4* sk = (const f32x4*)p.in[3]; const f32x4* sv = (const f32x4*)p.in[4];
      for (int i = blockIdx.x * NTHREADS + tid; i < 1048576; i += gridDim.x * NTHREADS) { const f32x4 a = sk[i], b = sv[i]; u32x2 x, y; x.x = pk2(a[0], a[1]); x.y = pk2(a[2], a[3]); y.x = pk2(b[0], b[1]); y.y = pk2(b[2], b[3]); ck[i] = x; cv[i] = y; } }
}

__device__ __forceinline__ void norm_mod_phase(const float* xa, const float* xb, const float* g, const float* mod, int sh_off, int sc_off, bf16_t* H, const float* fix, float* xfix) {
    const int tid_ = otid(); const int lane = tid_ & 63, wave = tid_ >> 6;
    for (int row = blockIdx.x * 8 + wave; row < MROWS; row += gridDim.x * 8) {
        const float* x = row < MCTX ? xa + (size_t)row * D : xb + (size_t)(row - MCTX) * D;
        f32x4 v[8]; float ss = 0.f;
#pragma unroll
        for (int i = 0; i < 8; ++i) v[i] = *(const f32x4*)(x + i * 256 + lane * 4);
        if (fix != nullptr && row >= 16384) { const float* f0 = fix + (size_t)(row - 16384) * D; const float* f1 = f0 + (size_t)4096 * D; float* xw = xfix + (size_t)row * D;
#pragma unroll
            for (int i = 0; i < 8; ++i) { v[i] += *(const f32x4*)(f0 + i * 256 + lane * 4) + *(const f32x4*)(f1 + i * 256 + lane * 4); *(f32x4*)(xw + i * 256 + lane * 4) = v[i]; } }
#pragma unroll
        for (int i = 0; i < 8; ++i) ss += v[i][0] * v[i][0] + v[i][1] * v[i][1] + v[i][2] * v[i][2] + v[i][3] * v[i][3];
#pragma unroll
        for (int o = 32; o >= 1; o >>= 1) ss += __shfl_xor(ss, o);
        const float rs = rsqrtf(ss * (1.f / 2048.f) + 1e-6f);
        const float* m = mod + (size_t)(row < MCTX ? 0 : 1 + ((row - MCTX) >> 12)) * 12288;
#pragma unroll
        for (int i = 0; i < 8; ++i) { const int e = i * 256 + lane * 4;
            const f32x4 gg = *(const f32x4*)(g + e), sc = *(const f32x4*)(m + sc_off + e), sh = *(const f32x4*)(m + sh_off + e);
            const f32x4 y = v[i] * rs * gg * (sc + 1.f) + sh;
            u32x2 w; w.x = pk2(y[0], y[1]); w.y = pk2(y[2], y[3]);
            *(u32x2*)(H + (size_t)row * D + e) = w; }
    }
}

__device__ __forceinline__ void finalize_phase(const bf16_t* OF, const bf16_t* QKV, const float* rg_, const float* mg_, bf16_t* MIX) {
    const int tid_ = otid(); const int lane = tid_ & 63, wave = tid_ >> 6;
    for (int row = blockIdx.x * 8 + wave; row < MROWS; row += gridDim.x * 8) {
#pragma unroll
        for (int mx = 0; mx < 2; ++mx) {
            const bf16_t* f = OF + (size_t)(mx * 2) * MROWS * 1024 + (size_t)row * 1024 + lane * 16;
            const bf16_t* b = f + (size_t)MROWS * 1024;
            const bf16_t* gt = QKV + (size_t)row * NQKV + (mx == 0 ? 6144 : 10240) + lane * 16;
            const float* ng = (mx == 0 ? rg_ : mg_) + lane * 16;
            float v[16], t[8];
            unpack8(*(const u32x4*)f, v); unpack8(*(const u32x4*)(f + 8), v + 8);
            unpack8(*(const u32x4*)b, t);
#pragma unroll
            for (int i = 0; i < 8; ++i) v[i] += t[i];
            unpack8(*(const u32x4*)(b + 8), t);
#pragma unroll
            for (int i = 0; i < 8; ++i) v[8 + i] += t[i];
            float ss = 0.f;
#pragma unroll
            for (int i = 0; i < 16; ++i) ss += v[i] * v[i];
            ss += __shfl_xor(ss, 1); ss += __shfl_xor(ss, 2); ss += __shfl_xor(ss, 4);
            const float rs = rsqrtf(ss * (1.f / 128.f) + 1e-6f);
            float gv[16];
            unpack8(*(const u32x4*)gt, gv); unpack8(*(const u32x4*)(gt + 8), gv + 8);
            float o[16];
#pragma unroll
            for (int i = 0; i < 16; ++i) { const float s = sigm(gv[i]); const float gate = (mx == 0) ? gv[i] * s : s; o[i] = v[i] * rs * ng[i] * gate; }
            bf16_t* dst = MIX + (size_t)row * 3072 + 1024 + mx * 1024 + lane * 16;
            *(u32x4*)dst = pack8(o); *(u32x4*)(dst + 8) = pack8(o + 8);
        }
    }
}

constexpr int RS = 272;
constexpr int L_QT = 0, L_KT = 17408, L_KS = 34816, L_VT = 52224, L_ST = 69632, L_VEC = 104448  , L_NV = 107520, L_RPB = 108032, L_NXT = 109952, L_NP = 110080;
constexpr int L_KT1 = 52224, L_VT0 = 34816, L_VT1 = 69632;

#define MFMA16(a, b, c) __builtin_amdgcn_mfma_f32_16x16x32_bf16(a, b, c, 0, 0, 0)

__device__ __forceinline__ float mlstm_vectors(LAS float* V, float ip, float fp, float mstate, int lane) {
    const float lf = fminf(fp, 0.f) - log1pf(__expf(-fabsf(fp)));
    float bc = lf;
#pragma unroll
    for (int o = 1; o < 64; o <<= 1) { const float t_ = __shfl_up(bc, o); if (lane >= o) bc += t_; }
    const float u = ip - bc;
    float pm = u;
#pragma unroll
    for (int o = 1; o < 64; o <<= 1) { const float t_ = __shfl_up(pm, o); if (lane >= o) pm = fmaxf(pm, t_); }
    const float mm = fmaxf(mstate, pm);
    const float pm63 = __shfl(pm, 63), bend = __shfl(bc, 63);
    const float mrel = fmaxf(mstate, pm63);
    V[lane] = -mm; V[64 + lane] = -u; V[128 + lane] = mstate - mm; V[192 + lane] = u - mrel; V[256 + lane] = __expf(-(bc + mm));
    if (lane == 0) V[320] = mstate - mrel;
    return bend + mrel;
}

template <bool MLSTM>
__device__ __forceinline__ void scan_unit(const Params& p, LAS unsigned char* lds, int l, int latent, int b, int h, int dir, int c_out0, int c_end) {
    const int tid = otid(), lane = tid & 63, w = __builtin_amdgcn_readfirstlane(tid >> 6), fr = lane & 15, fq = lane >> 4, qs = w & 3, dvh = w >> 2;
    const int tq = (lane & 15) >> 2, tp = lane & 3;
    unsigned char* ws = p.ws;
    const bf16_t* QKV = (const bf16_t*)(ws + WS_R2);
    const float* MG = (const float*)(ws + WS_MGATE);
    const float* ROPE = (const float*)(ws + WS_ROPE);
    bf16_t* OF = (bf16_t*)(ws + WS_R1) + (size_t)((MLSTM ? 2 : 0) + dir) * MROWS * 1024;
    const int T = latent ? 4096 : 256, nch = c_end, row_base = latent ? MCTX + b * 4096 : b * 256;
    const int qcol = (MLSTM ? 7168 : 3072) + h * 128;
    LAS float* NV = (LAS float*)(lds + L_NV);
    LAS float* NP = (LAS float*)(lds + L_NP);
    const bool rope = (!MLSTM) && latent;
    const int ls = tid >> 3, lj = tid & 7, c1 = (lj & 3) + 8 * (lj >> 2), c2 = c1 + 4;

    f32x4 st[8];
    const size_t sidx = (size_t)(((b * 2 + l) * 2 + dir) * 8 + h);
    if (latent) {
        const float* S0 = (MLSTM ? p.in[6] : p.in[5]) + sidx * 16384;
#pragma unroll
        for (int t = 0; t < 8; ++t)
#pragma unroll
            for (int j = 0; j < 4; ++j) st[t][j] = S0[(16 * w + fq * 4 + j) * 128 + 16 * t + fr];
    } else {
#pragma unroll
        for (int t = 0; t < 8; ++t) st[t] = (f32x4){0.f, 0.f, 0.f, 0.f};
    }
#pragma unroll
    for (int t = 0; t < 8; ++t) { u32x2 x; x.x = pk2(st[t][0], st[t][1]); x.y = pk2(st[t][2], st[t][3]); *(LAS u32x2*)(lds + L_ST + (16 * t + fr) * RS + (16 * w + fq * 4) * 2) = x; }
    float mstate = 0.f;
    float gbi = 0.f, gbf = 0.f;
    if (MLSTM) {
        if (tid < 128) NV[tid] = latent ? p.in[7][sidx * 128 + tid] : 0.f;
        mstate = latent ? p.in[8][sidx] : 0.f;
        gbi = p.in[15][l * 32 + (2 * dir) * 8 + h]; gbf = p.in[15][l * 32 + (2 * dir + 1) * 8 + h];
    } else {
        if (tid < 128) { const int t_ = tid & 63; LAS float* V = (LAS float*)(lds + L_VEC + (tid >> 6) * 1536);
            const float dcy = p.in[19][(l * 2 + dir) * 8 + h]; const float lg = fminf(dcy, 0.f) - log1pf(__expf(-fabsf(dcy)));
            V[t_] = t_ * lg; V[64 + t_] = t_ * lg; V[128 + t_] = (t_ + 1) * lg; V[192 + t_] = (63 - t_) * lg; V[256 + t_] = 0.f; if (t_ == 0) V[320] = 64.f * lg; }
    }
    u32x4 pq1 = (u32x4){0u, 0u, 0u, 0u}, pq2 = pq1, pk1, pk2_, pv1, pv2; float gip = 0.f, gfp = 0.f;
#define SC_PREFETCH(cc) do { const int tok_ = dir ? T - 1 - ((cc) * 64 + ls) : (cc) * 64 + ls; const bf16_t* src_ = QKV + (size_t)(row_base + tok_) * NQKV + qcol; \
        if ((cc) >= c_out0) { pq1 = *(const u32x4*)(src_ + c1 * 8); pq2 = *(const u32x4*)(src_ + c2 * 8); } pk1 = *(const u32x4*)(src_ + 1024 + c1 * 8); pk2_ = *(const u32x4*)(src_ + 1024 + c2 * 8); \
        pv1 = *(const u32x4*)(src_ + 2048 + c1 * 8); pv2 = *(const u32x4*)(src_ + 2048 + c2 * 8); \
        if (MLSTM && w == 0) { const int tk_ = dir ? T - 1 - ((cc) * 64 + lane) : (cc) * 64 + lane; const float* mg_ = MG + (size_t)(row_base + tk_) * 32; gip = mg_[(2 * dir) * 8 + h] + gbi; gfp = mg_[(2 * dir + 1) * 8 + h] + gbf; } } while (0)
#define SC_WRITE(cc, V_) do { const int tok_ = dir ? T - 1 - ((cc) * 64 + ls) : (cc) * 64 + ls; float cs_[8], sn_[8], x1_[8], x2_[8]; \
        if (rope) { const int pos_ = (lj < 4) ? (tok_ >> 6) : (tok_ & 63); const float* rp_ = ROPE + pos_ * 32 + 8 * (lj & 3); \
            *(f32x4*)cs_ = *(const f32x4*)rp_; *(f32x4*)(cs_ + 4) = *(const f32x4*)(rp_ + 4); *(f32x4*)sn_ = *(const f32x4*)(rp_ + 2048); *(f32x4*)(sn_ + 4) = *(const f32x4*)(rp_ + 2052); } \
        if ((cc) >= c_out0) { unpack8(pq1, x1_); unpack8(pq2, x2_); \
        if (rope) { _Pragma("unroll") for (int e = 0; e < 8; ++e) { const float a_ = x1_[e], b_ = x2_[e]; x1_[e] = a_ * cs_[e] - b_ * sn_[e]; x2_[e] = b_ * cs_[e] + a_ * sn_[e]; } } \
        *(LAS u32x4*)(lds + L_QT + ls * RS + c1 * 16) = pack8(x1_); *(LAS u32x4*)(lds + L_QT + ls * RS + c2 * 16) = pack8(x2_); } \
        unpack8(pk1, x1_); unpack8(pk2_, x2_); \
        if (rope) { _Pragma("unroll") for (int e = 0; e < 8; ++e) { const float a_ = x1_[e], b_ = x2_[e]; x1_[e] = a_ * cs_[e] - b_ * sn_[e]; x2_[e] = b_ * cs_[e] + a_ * sn_[e]; } } \
        _Pragma("unroll") for (int e = 0; e < 8; ++e) { x1_[e] *= 0.08838834764831845f; x2_[e] *= 0.08838834764831845f; } \
        *(LAS u32x4*)(lds + L_KT + ls * RS + c1 * 16) = pack8(x1_); *(LAS u32x4*)(lds + L_KT + ls * RS + c2 * 16) = pack8(x2_); \
        const float kw_ = __expf((V_)[192 + ls]); \
        _Pragma("unroll") for (int e = 0; e < 8; ++e) { x1_[e] *= kw_; x2_[e] *= kw_; } \
        *(LAS u32x4*)(lds + L_KS + ls * RS + c1 * 16) = pack8(x1_); *(LAS u32x4*)(lds + L_KS + ls * RS + c2 * 16) = pack8(x2_); \
        *(LAS u32x4*)(lds + L_VT + ls * RS + c1 * 16) = pv1; *(LAS u32x4*)(lds + L_VT + ls * RS + c2 * 16) = pv2; } while (0)

    SC_PREFETCH(0);
    if (MLSTM && w == 0) mstate = mlstm_vectors((LAS float*)(lds + L_VEC), gip, gfp, mstate, lane);
    __syncthreads();
    { LAS float* V0 = (LAS float*)(lds + L_VEC); SC_WRITE(0, V0); }
    __syncthreads();

    for (int c = 0; c < nch; ++c) {
        LAS float* VA = (LAS float*)(lds + L_VEC + (c & 1) * 1536); LAS float* VB = VA + 64; LAS float* VE = VA + 128; LAS float* VFL = VA + 256;
        LAS float* VN = (LAS float*)(lds + L_VEC + ((c + 1) & 1) * 1536);
        const bool has_next = (c + 1 < nch);
        if (has_next) SC_PREFETCH(c + 1);
        const float cdec = __expf(VA[320]);
        if (c >= c_out0) {
            bf16x8 qf[4];
#pragma unroll
            for (int ks = 0; ks < 4; ++ks) qf[ks] = *(const LAS bf16x8*)(lds + L_QT + (qs * 16 + fr) * RS + (ks * 32 + fq * 8) * 2);
            f32x4 sacc[4];
#pragma unroll
            for (int kt = 0; kt < 4; ++kt) sacc[kt] = (f32x4){0.f, 0.f, 0.f, 0.f};
#pragma unroll
            for (int ks = 0; ks < 4; ++ks) {
                bf16x8 kf[4];
#pragma unroll
                for (int kt = 0; kt < 4; ++kt) kf[kt] = *(const LAS bf16x8*)(lds + L_KT + (kt * 16 + fr) * RS + (ks * 32 + fq * 8) * 2);
#pragma unroll
                for (int kt = 0; kt < 4; ++kt) sacc[kt] = MFMA16(kf[kt], qf[ks], sacc[kt]);
            }
            const int tql = qs * 16 + fr;
            const float Aq = VA[tql];
            float rowsum = 0.f;
#pragma unroll
            for (int kt = 0; kt < 4; ++kt) { const f32x4 bv = *(const LAS f32x4*)(VB + kt * 16 + fq * 4);
#pragma unroll
                for (int j = 0; j < 4; ++j) { const int s = kt * 16 + fq * 4 + j; const float wgt = (s <= tql) ? __expf(Aq - bv[j]) : 0.f; sacc[kt][j] *= wgt; rowsum += sacc[kt][j]; } }
            bf16x8 pa[2];
#pragma unroll
            for (int pp = 0; pp < 2; ++pp) { const u32x4 x = (u32x4){pk2(sacc[2 * pp][0], sacc[2 * pp][1]), pk2(sacc[2 * pp][2], sacc[2 * pp][3]), pk2(sacc[2 * pp + 1][0], sacc[2 * pp + 1][1]), pk2(sacc[2 * pp + 1][2], sacc[2 * pp + 1][3])}; pa[pp] = __builtin_bit_cast(bf16x8, x); }
            float invq[4] = {1.f, 1.f, 1.f, 1.f};
            if (MLSTM) {
                rowsum += __shfl_xor(rowsum, 16); rowsum += __shfl_xor(rowsum, 32);
                float qn = 0.f;
#pragma unroll
                for (int ks = 0; ks < 4; ++ks) { const f32x4 n0 = *(const LAS f32x4*)(NV + ks * 32 + fq * 8), n1 = *(const LAS f32x4*)(NV + ks * 32 + fq * 8 + 4);
#pragma unroll
                    for (int e = 0; e < 4; ++e) { qn += bf2f((unsigned short)qf[ks][e]) * n0[e]; qn += bf2f((unsigned short)qf[ks][4 + e]) * n1[e]; } }
                qn += __shfl_xor(qn, 16); qn += __shfl_xor(qn, 32);
                const float den = rowsum + __expf(VE[tql]) * qn;
                const float inv = 1.f / fmaxf(fabsf(den), VFL[tql]);
#pragma unroll
                for (int j = 0; j < 4; ++j) invq[j] = __shfl(inv, fq * 4 + j);
            }
            float aw[4];
#pragma unroll
            for (int j = 0; j < 4; ++j) aw[j] = __expf(VE[qs * 16 + fq * 4 + j]);
#pragma unroll
            for (int t = 0; t < 4; ++t) {
                f32x4 o = (f32x4){0.f, 0.f, 0.f, 0.f}, oi = (f32x4){0.f, 0.f, 0.f, 0.f};
                const int dvc = dvh * 64 + t * 16;
#pragma unroll
                for (int pp = 0; pp < 2; ++pp) {
                    const s16x4 r1 = trr(lds + L_VT + (32 * pp + fq * 4 + tq) * RS + (dvc + 4 * tp) * 2), r2 = trr(lds + L_VT + (32 * pp + 16 + fq * 4 + tq) * RS + (dvc + 4 * tp) * 2);
                    o = MFMA16(pa[pp], cat4(r1, r2), o); }
#pragma unroll
                for (int ks = 0; ks < 4; ++ks) { const bf16x8 sf = *(const LAS bf16x8*)(lds + L_ST + (dvc + fr) * RS + (ks * 32 + fq * 8) * 2); oi = MFMA16(qf[ks], sf, oi); }
#pragma unroll
                for (int j = 0; j < 4; ++j) { const int ql = qs * 16 + fq * 4 + j; const int tok = dir ? T - 1 - (c * 64 + ql) : c * 64 + ql;
                    const float val = (o[j] + aw[j] * oi[j]) * invq[j];
                    OF[(size_t)(row_base + tok) * 1024 + h * 128 + dvc + fr] = (bf16_t)f2bf(val); }
            }
        }
#pragma unroll
        for (int t = 0; t < 8; ++t) st[t] *= cdec;
#pragma unroll
        for (int pp = 0; pp < 2; ++pp) {
            const s16x4 a1 = trr(lds + L_KS + (32 * pp + fq * 8 + tq) * RS + (16 * w + 4 * tp) * 2), a2 = trr(lds + L_KS + (32 * pp + fq * 8 + 4 + tq) * RS + (16 * w + 4 * tp) * 2);
            const bf16x8 af = cat4(a1, a2);
#pragma unroll
            for (int t = 0; t < 8; ++t) { const s16x4 b1 = trr(lds + L_VT + (32 * pp + fq * 8 + tq) * RS + (16 * t + 4 * tp) * 2), b2 = trr(lds + L_VT + (32 * pp + fq * 8 + 4 + tq) * RS + (16 * t + 4 * tp) * 2);
                st[t] = MFMA16(af, cat4(b1, b2), st[t]); }
        }
        if (MLSTM) { float na = 0.f; const int d_ = tid & 127, s0_ = (tid >> 7) * 16;
#pragma unroll
            for (int s = 0; s < 16; ++s) na += bf2f(*(const LAS unsigned short*)(lds + L_KS + (s0_ + s) * RS + d_ * 2));
            NP[tid] = na; }
        if (MLSTM && w == 0 && has_next) mstate = mlstm_vectors(VN, gip, gfp, mstate, lane);
        __syncthreads();
        if (c + 1 >= c_out0) {
#pragma unroll
        for (int t = 0; t < 8; ++t) { u32x2 x; x.x = pk2(st[t][0], st[t][1]); x.y = pk2(st[t][2], st[t][3]); *(LAS u32x2*)(lds + L_ST + (16 * t + fr) * RS + (16 * w + fq * 4) * 2) = x; } }
        if (MLSTM && tid < 128) NV[tid] = cdec * NV[tid] + ((NP[tid] + NP[128 + tid]) + (NP[256 + tid] + NP[384 + tid]));
        if (has_next) SC_WRITE(c + 1, VN);
        __syncthreads();
    }
#undef SC_PREFETCH
#undef SC_WRITE
    if (!latent) {
        float* So = p.out + (MLSTM ? OUT_MC : OUT_RET) + sidx * 16384;
#pragma unroll
        for (int t = 0; t < 8; ++t)
#pragma unroll
            for (int j = 0; j < 4; ++j) So[(16 * w + fq * 4 + j) * 128 + 16 * t + fr] = st[t][j];
        if (MLSTM) {
            if (tid < 128) p.out[OUT_MN + sidx * 128 + tid] = NV[tid];
            if (tid == 0) p.out[OUT_MM + sidx] = mstate;
        }
    }
}

constexpr int A_Q = 0, A_K0 = 34816, A_V0 = 52224, A_K1 = 69632, A_V1 = 87040;
template <bool LAT>
__device__ __forceinline__ void attn_unit(const Params& p, LAS unsigned char* lds, int l, int b, int h, int rp) {
    const int tid = otid(), lane = tid & 63, w = __builtin_amdgcn_readfirstlane(tid >> 6), fr = lane & 15, fq = lane >> 4, qs = w & 3;
    const int tq = (lane & 15) >> 2, tp = lane & 3;
    unsigned char* ws = p.ws;
    const bf16_t* QKV = (const bf16_t*)(ws + WS_R2);
    bf16_t* MIX = (bf16_t*)(ws + WS_R4);
    const int s_ = tid >> 3, j_ = tid & 7;
    const int r0 = 2 * rp;
    const int qrow0 = LAT ? MCTX + b * 4096 + r0 * 64 : b * 256 + rp * 128;
    const int rsA = LAT ? min(max(r0 - 4, 0), 56) : 0, rsB = LAT ? min(max(r0 - 3, 0), 56) : 0;
    const int nl = LAT ? rsB + 8 - rsA : 0;
    const int ntiles = LAT ? nl + 8 : 4;
    const int rw = r0 + (w >> 2), rsw = (w >> 2) ? rsB : rsA;
    LAS float* RPB = (LAS float*)(lds + L_RPB);
    if (LAT) { for (int i = tid; i < 465; i += NTHREADS) RPB[i] = p.in[18][(size_t)(l * 8 + h) * 465 + i] * 1.4426950408889634f; }
    float gk[16];
    { const float* g_ = p.in[17] + l * 128 + j_ * 16;
#pragma unroll
      for (int e = 0; e < 4; ++e) { const f32x4 t_ = *(const f32x4*)(g_ + 4 * e); gk[4 * e] = t_[0]; gk[4 * e + 1] = t_[1]; gk[4 * e + 2] = t_[2]; gk[4 * e + 3] = t_[3]; } }
    u32x4 pk0, pk1, pv0, pv1;
#define AT_LOAD(kt_) do { if (LAT && (kt_) >= nl) { const size_t off_ = ((size_t)((b * 2 + l) * 512 + ((kt_) - nl) * 64 + s_)) * 1024 + h * 128 + j_ * 16; \
            const bf16_t* ck_ = (const bf16_t*)(ws + WS_CK) + off_; const bf16_t* cv_ = (const bf16_t*)(ws + WS_CV) + off_; \
            pk0 = *(const u32x4*)ck_; pk1 = *(const u32x4*)(ck_ + 8); pv0 = *(const u32x4*)cv_; pv1 = *(const u32x4*)(cv_ + 8); \
        } else { const int krow_ = LAT ? MCTX + b * 4096 + (rsA + (kt_)) * 64 + s_ : b * 256 + (kt_) * 64 + s_; \
            const bf16_t* src_ = QKV + (size_t)krow_ * NQKV + 1024 + h * 128 + j_ * 16; \
            pk0 = *(const u32x4*)src_; pk1 = *(const u32x4*)(src_ + 8); pv0 = *(const u32x4*)(src_ + 1024); pv1 = *(const u32x4*)(src_ + 1032); } } while (0)
#define AT_STORE(kt_) do { const int kb_ = ((kt_) & 1) ? A_K1 : A_K0, vb_ = ((kt_) & 1) ? A_V1 : A_V0; \
        if (LAT && (kt_) >= nl) { *(LAS u32x4*)(lds + kb_ + s_ * RS + j_ * 32) = pk0; *(LAS u32x4*)(lds + kb_ + s_ * RS + j_ * 32 + 16) = pk1; } \
        else { float x_[16]; unpack8(pk0, x_); unpack8(pk1, x_ + 8); float ss_ = 0.f; \
            _Pragma("unroll") for (int e = 0; e < 16; ++e) ss_ += x_[e] * x_[e]; \
            ss_ += __shfl_xor(ss_, 1); ss_ += __shfl_xor(ss_, 2); ss_ += __shfl_xor(ss_, 4); \
            const float rs_ = rsqrtf(ss_ * (1.f / 128.f) + 1e-6f); \
            _Pragma("unroll") for (int e = 0; e < 16; ++e) x_[e] *= rs_ * gk[e]; \
            *(LAS u32x4*)(lds + kb_ + s_ * RS + j_ * 32) = pack8(x_); *(LAS u32x4*)(lds + kb_ + s_ * RS + j_ * 32 + 16) = pack8(x_ + 8); \
            if (!LAT && rp == 0) { const size_t oo_ = ((size_t)((b * 2 + l) * 256 + (kt_) * 64 + s_)) * 1024 + h * 128 + j_ * 16; \
                float* ok_ = p.out + OUT_NAK + oo_; float* ov_ = p.out + OUT_NAV + oo_; \
                _Pragma("unroll") for (int e = 0; e < 4; ++e) *(f32x4*)(ok_ + 4 * e) = (f32x4){x_[4 * e], x_[4 * e + 1], x_[4 * e + 2], x_[4 * e + 3]}; \
                float vf_[16]; unpack8(pv0, vf_); unpack8(pv1, vf_ + 8); \
                _Pragma("unroll") for (int e = 0; e < 4; ++e) *(f32x4*)(ov_ + 4 * e) = (f32x4){vf_[4 * e], vf_[4 * e + 1], vf_[4 * e + 2], vf_[4 * e + 3]}; } } \
        *(LAS u32x4*)(lds + vb_ + s_ * RS + j_ * 32) = pv0; *(LAS u32x4*)(lds + vb_ + s_ * RS + j_ * 32 + 16) = pv1; } while (0)
    AT_LOAD(0);
    {
        const float* g = p.in[16] + l * 128 + j_ * 16;
#pragma unroll
        for (int hh = 0; hh < 2; ++hh) {
            const int qr = s_ + 64 * hh;
            const bf16_t* src = QKV + (size_t)(qrow0 + qr) * NQKV + h * 128 + j_ * 16;
            float x[16]; unpack8(*(const u32x4*)src, x); unpack8(*(const u32x4*)(src + 8), x + 8);
            float ss = 0.f;
#pragma unroll
            for (int e = 0; e < 16; ++e) ss += x[e] * x[e];
            ss += __shfl_xor(ss, 1); ss += __shfl_xor(ss, 2); ss += __shfl_xor(ss, 4);
            const float rs = rsqrtf(ss * (1.f / 128.f) + 1e-6f) * (0.08838834764831845f * 1.4426950408889634f);
#pragma unroll
            for (int e = 0; e < 16; ++e) x[e] *= rs * g[e];
            *(LAS u32x4*)(lds + A_Q + qr * RS + j_ * 32) = pack8(x); *(LAS u32x4*)(lds + A_Q + qr * RS + j_ * 32 + 16) = pack8(x + 8);
        }
    }
    AT_STORE(0);
    __syncthreads();
    float mrun = -INFINITY, lrun = 0.f;
    f32x4 o[8];
#pragma unroll
    for (int t = 0; t < 8; ++t) o[t] = (f32x4){0.f, 0.f, 0.f, 0.f};
    bf16x8 qf[4];
#pragma unroll
    for (int ks = 0; ks < 4; ++ks) qf[ks] = *(const LAS bf16x8*)(lds + A_Q + (w * 16 + fr) * RS + (ks * 32 + fq * 8) * 2);
    const int qc = qs * 16 + fr, cs0 = min(max(qc - 8, 0), 48);
    for (int kt = 0; kt < ntiles; ++kt) {
        const bool has_next = kt + 1 < ntiles;
        if (has_next) AT_LOAD(kt + 1);
        const int kb = (kt & 1) ? A_K1 : A_K0, vb = (kt & 1) ? A_V1 : A_V0;
        const bool local = LAT && kt < nl;
        const int g = rsA + kt;
        const bool active = !local || (g >= rsw && g < rsw + 8);
        if (active) {
            f32x4 sacc[4];
#pragma unroll
            for (int k16 = 0; k16 < 4; ++k16) sacc[k16] = (f32x4){0.f, 0.f, 0.f, 0.f};
#pragma unroll
            for (int ks = 0; ks < 4; ++ks) {
                bf16x8 kf[4];
#pragma unroll
                for (int k16 = 0; k16 < 4; ++k16) kf[k16] = *(const LAS bf16x8*)(lds + kb + (k16 * 16 + fr) * RS + (ks * 32 + fq * 8) * 2);
#pragma unroll
                for (int k16 = 0; k16 < 4; ++k16) sacc[k16] = MFMA16(kf[k16], qf[ks], sacc[k16]);
            }
            if (local) {
                const volatile LAS float* rb = (const volatile LAS float*)(RPB + (g - rw + 7) * 31 + (fq * 4 - qc + 15));
                float bia[4][4];
#pragma unroll
                for (int k16 = 0; k16 < 4; ++k16)
#pragma unroll
                    for (int j = 0; j < 4; ++j) bia[k16][j] = rb[k16 * 16 + j];
#pragma unroll
                for (int k16 = 0; k16 < 4; ++k16)
#pragma unroll
                    for (int j = 0; j < 4; ++j) { const bool ok = (unsigned)(k16 * 16 + fq * 4 + j - cs0) < 16u; sacc[k16][j] = ok ? sacc[k16][j] + bia[k16][j] : -INFINITY; }
            }
            float tmax = -INFINITY;
#pragma unroll
            for (int k16 = 0; k16 < 4; ++k16)
#pragma unroll
                for (int j = 0; j < 4; ++j) tmax = fmaxf(tmax, sacc[k16][j]);
            tmax = fmaxf(tmax, __shfl_xor(tmax, 16)); tmax = fmaxf(tmax, __shfl_xor(tmax, 32));
            const float mnew = fmaxf(mrun, tmax);
            const float alpha = __builtin_amdgcn_exp2f(mrun - mnew);
            float psum = 0.f;
#pragma unroll
            for (int k16 = 0; k16 < 4; ++k16)
#pragma unroll
                for (int j = 0; j < 4; ++j) { const float pv = __builtin_amdgcn_exp2f(sacc[k16][j] - mnew); sacc[k16][j] = pv; psum += pv; }
            psum += __shfl_xor(psum, 16); psum += __shfl_xor(psum, 32);
            lrun = lrun * alpha + psum; mrun = mnew;
            float al[4];
#pragma unroll
            for (int j = 0; j < 4; ++j) al[j] = __shfl(alpha, fq * 4 + j);
            bf16x8 pa[2];
#pragma unroll
            for (int pp = 0; pp < 2; ++pp) { const u32x4 x = (u32x4){pk2(sacc[2 * pp][0], sacc[2 * pp][1]), pk2(sacc[2 * pp][2], sacc[2 * pp][3]), pk2(sacc[2 * pp + 1][0], sacc[2 * pp + 1][1]), pk2(sacc[2 * pp + 1][2], sacc[2 * pp + 1][3])}; pa[pp] = __builtin_bit_cast(bf16x8, x); }
#pragma unroll
            for (int t = 0; t < 8; ++t) {
                const int dvc = t * 16;
#pragma unroll
                for (int j = 0; j < 4; ++j) o[t][j] *= al[j];
#pragma unroll
                for (int pp = 0; pp < 2; ++pp) {
                    const s16x4 r1 = trr(lds + vb + (32 * pp + fq * 4 + tq) * RS + (dvc + 4 * tp) * 2), r2 = trr(lds + vb + (32 * pp + 16 + fq * 4 + tq) * RS + (dvc + 4 * tp) * 2);
                    o[t] = MFMA16(pa[pp], cat4(r1, r2), o[t]); }
            }
        }
        if (has_next) AT_STORE(kt + 1);
        __syncthreads();
    }
#undef AT_LOAD
#undef AT_STORE
    const float inv = 1.f / lrun;
    float iv[4];
#pragma unroll
    for (int j = 0; j < 4; ++j) iv[j] = __shfl(inv, fq * 4 + j);
#pragma unroll
    for (int t = 0; t < 8; ++t)
#pragma unroll
        for (int j = 0; j < 4; ++j) MIX[(size_t)(qrow0 + w * 16 + fq * 4 + j) * 3072 + h * 128 + t * 16 + fr] = (bf16_t)f2bf(o[t][j] * iv[j]);
}

__device__ __forceinline__ void mixer_phase(const Params& p, LAS unsigned char* lds, int l) {
    unsigned* ctr = (unsigned*)(p.ws + WS_CTR) + l;
    LAS int* nxt = (LAS int*)(lds + L_NXT);
    for (;;) {
        __syncthreads();
        if (threadIdx.x == 0) *nxt = (int)atomicAdd(ctr, 1u);
        __syncthreads();
        const int u = *nxt;
        if (u >= 2048) break;
        if (u < 256) { const int half = (u < 128) ? 1 : 0, uu = u & 127, mix = uu >> 6, rem = uu & 63, b = rem >> 4, h = (rem >> 1) & 7, dir = rem & 1;
            if (half == 0) continue;
            int z = 0; asm volatile("" : "+s"(z));
            if (mix) scan_unit<true>(p, lds, l, 1, b, h, dir, half * z, 32 + half * 32); else scan_unit<false>(p, lds, l, 1, b, h, dir, half * z, 32 + half * 32); }
        else if (u < 1280) { const int v = u - 256; attn_unit<true>(p, lds, l, v >> 8, (v >> 5) & 7, v & 31); }
        else if (u < 1792) { const int v = u - 1280, mix = v >> 8, rem = v & 255, b = rem >> 4, h = (rem >> 1) & 7, dir = rem & 1;
            if (mix) scan_unit<true>(p, lds, l, 0, b, h, dir, 0, 4); else scan_unit<false>(p, lds, l, 0, b, h, dir, 0, 4); }
        else { const int v = u - 1792; attn_unit<false>(p, lds, l, v >> 4, (v >> 1) & 7, v & 1); }
    }
}

#define XB_TMO      128
#define XB_XCNT(j)  (256  + 64 * (j))
#define XB_XSUB(j)  (1280 + 64 * (j))
#define XB_XGEN(j)  (2304 + 64 * (j))
#define XB_TOP      3328
#define XB_TOPGEN   3392
#define XCD_BAR_WORDS 3456
#define XB_SPIN_CAP (1u << 18)

__device__ __forceinline__ unsigned xb_ld(unsigned* p)              { return __hip_atomic_load(p, __ATOMIC_RELAXED, __HIP_MEMORY_SCOPE_AGENT); }
__device__ __forceinline__ unsigned xb_add(unsigned* p, unsigned v) { return __hip_atomic_fetch_add(p, v, __ATOMIC_RELAXED, __HIP_MEMORY_SCOPE_AGENT); }
__device__ __forceinline__ unsigned xb_xcc_id() { return (unsigned)__builtin_amdgcn_s_getreg((3 << 11) | 20) & 0xFu; }
#define XB_SPIN(cond, bar) do { unsigned _sp = 0; while (cond) { __builtin_amdgcn_s_sleep(1); \
    if ((++_sp & 255u) == 0u) { if (xb_ld(&(bar)[XB_TMO])) break; if (_sp > XB_SPIN_CAP) { atomicAdd(&(bar)[XB_TMO], 1u); break; } } } } while (0)

struct XcdBarrier {
    unsigned* bar; unsigned x;
    volatile LAS unsigned* st;
};

__device__ __forceinline__ XcdBarrier xcd_barrier_post(unsigned* bar, volatile LAS unsigned* st) {
    XcdBarrier b; b.bar = bar; b.x = xb_xcc_id(); b.st = st;
    if (threadIdx.x == 0) (void)xb_add(&bar[XB_XCNT(b.x)], 1u);
    return b;
}
__device__ __forceinline__ void xcd_barrier_complete(unsigned* bar, unsigned x, unsigned& nloc, unsigned& nx) {
    const unsigned G = gridDim.x * gridDim.y * gridDim.z;
    unsigned sum, cnt, mine, sp = 0u;
    for (;;) {
        sum = 0u; cnt = 0u; mine = 0u;
#pragma unroll
        for (unsigned j = 0; j < 16; ++j) { const unsigned c = xb_ld(&bar[XB_XCNT(j)]); sum += c; cnt += (c > 0u) ? 1u : 0u; mine = (j == x) ? c : mine; }
        if (sum == G) break;
        __builtin_amdgcn_s_sleep(1);
        if ((++sp & 255u) == 0u) { if (xb_ld(&bar[XB_TMO])) break; if (sp > XB_SPIN_CAP) { atomicAdd(&bar[XB_TMO], 1u); break; } }
    }
    nloc = mine > 0u ? mine : 1u; nx = cnt > 0u ? cnt : 1u;
}

__device__ __forceinline__ void xcd_barrier(const XcdBarrier& b) {
    asm volatile("s_waitcnt vmcnt(0)" ::: "memory");
    __syncthreads();
    if (threadIdx.x == 0) {
        unsigned* bar = b.bar;
        __builtin_amdgcn_s_waitcnt(0);
        unsigned nloc = b.st[0], nx = b.st[1];
        if (nloc == 0u) { xcd_barrier_complete(bar, b.x, nloc, nx); b.st[0] = nloc; b.st[1] = nx; }
        const unsigned old = xb_add(&bar[XB_XSUB(b.x)], 1u);
        const unsigned gen = old / nloc;
        if (old + 1u == (gen + 1u) * nloc) {
            __builtin_amdgcn_fence(__ATOMIC_RELEASE, "agent");
            asm volatile("s_waitcnt vmcnt(0)" ::: "memory");
            const unsigned og = xb_add(&bar[XB_TOP], 1u);
            const unsigned tg = og / nx;
            if (og + 1u == (tg + 1u) * nx) xb_add(&bar[XB_TOPGEN], 1u);
            else XB_SPIN(xb_ld(&bar[XB_TOPGEN]) == tg, bar);
            __builtin_amdgcn_fence(__ATOMIC_ACQUIRE, "agent");
            xb_add(&bar[XB_XGEN(b.x)], 1u);
            asm volatile("s_waitcnt vmcnt(0)" ::: "memory");
        } else {
            XB_SPIN(xb_ld(&bar[XB_XGEN(b.x)]) == gen, bar);
            __builtin_amdgcn_fence(__ATOMIC_ACQUIRE, "agent");
            asm volatile("s_waitcnt vmcnt(0)" ::: "memory");
        }
    }
    __syncthreads();
}

__global__ void __launch_bounds__(NTHREADS) mega(Params p) {
    extern __shared__ __attribute__((aligned(16))) unsigned char smem[];
    LAS unsigned char* lds = (LAS unsigned char*)smem;
    cg::grid_group grid = cg::this_grid();
    volatile LAS unsigned* xst = (volatile LAS unsigned*)(lds + 131072 + 64);
    if (threadIdx.x < 2) xst[threadIdx.x] = 0u;
    __syncthreads();
    const XcdBarrier xbar = xcd_barrier_post((unsigned*)(p.ws + WS_BAR), xst);
    unsigned char* ws = p.ws;
    const int G = gridDim.x, c = blockIdx.x;
    bf16_t* H = (bf16_t*)(ws + WS_R1);
    bf16_t* QKV = (bf16_t*)(ws + WS_R2);
    bf16_t* GATES = (bf16_t*)(ws + WS_R3);
    bf16_t* MIX = (bf16_t*)(ws + WS_R4);
    float* X = p.out;

    p0_misc(p, lds);
    __syncthreads();
    conv_layer(p, 0, lds);
    if (p.ws == nullptr) grid.sync();
    xcd_barrier(xbar);
    for (int l = 0; l < 2; ++l) {
        const float* mod = (const float*)(ws + WS_MOD) + (size_t)l * 5 * 12288;
        const float* xa = l == 0 ? p.in[0] : X; const float* xb = l == 0 ? p.in[1] : X + (size_t)MCTX * D;
        if (l > 0) conv_layer(p, l, lds);
        norm_mod_phase(xa, xb, p.in[12] + l * D, mod, 0, 2048, H, l > 0 ? (const float*)(ws + WS_R3) : nullptr, X);
        xcd_barrier(xbar);
        { pg8::Gemm g{H, (const bf16_t*)(ws + WS_R4), MROWS, NPROJ, D, D, 0}; pg8::StaticOrder S; S.init(MROWS, NPROJ, D, G, c);
          EpiProj E{QKV, GATES, (float*)(ws + WS_MGATE)}; pg8::gemm_phase(lds, g, S, E); }
        xcd_barrier(xbar);
        mixer_phase(p, lds, l);
        xcd_barrier(xbar);
        finalize_phase((const bf16_t*)(ws + WS_R1), QKV, p.in[20] + l * 1024, p.in[21] + l * 1024, MIX);
        xcd_barrier(xbar);
        { pg8::Gemm g{MIX, (const bf16_t*)(ws + WS_WBR), MROWS, D, 1024, 3072, 1024}; pg8::BranchOrder S; S.init(MROWS, D, 1024, G, c);
          EpiBranch E{GATES, (bf16_t*)(ws + WS_R1), QKV}; pg8::gemm_phase(lds, g, S, E); }
        xcd_barrier(xbar);
        { pg8::Gemm g{QKV, (const bf16_t*)(ws + WS_WOUT3), MROWS, D, D, D, 0}; pg8::StaticOrder S; S.init(MROWS, D, D, G, c);
          EpiResid E{xa, xb, X, mod, 4096}; pg8::gemm_phase(lds, g, S, E); }
        xcd_barrier(xbar);
        norm_mod_phase(X, X + (size_t)MCTX * D, p.in[13] + l * D, mod, 6144, 8192, H, nullptr, nullptr);
        xcd_barrier(xbar);
        { pg8::Gemm g{H, (const bf16_t*)(ws + WS_FF1), MROWS, FFD, D, D, 0}; pg8::StaticOrder S; S.init(MROWS, FFD, D, G, c);
          EpiRelu2 E{QKV}; pg8::gemm_phase(lds, g, S, E); }
        xcd_barrier(xbar);
        { pg8::Gemm g{QKV, (const bf16_t*)(ws + WS_FF2), MROWS, D, FFD, FFD, 0}; pg8::SplitTailOrder S; S.init(MROWS, D, FFD, 64, G, c);
          EpiResidSplit E{X, (float*)(ws + WS_R3), mod, 10240}; pg8::gemm_phase(lds, g, S, E); }
        xcd_barrier(xbar);
    }
    { const int tid = otid(); const float* f0 = (const float*)(ws + WS_R3); const float* f1 = f0 + (size_t)4096 * D; float* xo = X + (size_t)16384 * D;
      for (int i = blockIdx.x * NTHREADS + tid; i < 4096 * D / 4; i += gridDim.x * NTHREADS) { f32x4 v = ((const f32x4*)xo)[i]; v += ((const f32x4*)f0)[i] + ((const f32x4*)f1)[i]; ((f32x4*)xo)[i] = v; } }
}

extern "C" void kernel_launch(void* const* d_in, const int* in_sizes, int n_in, void* d_out, int out_size, void* d_ws, size_t ws_size, hipStream_t stream) {
    static int grid = 0;
    if (grid == 0) {
        if (n_in != 28 || ws_size < WS_END) { fprintf(stderr, "kernel_launch: unexpected inputs (n_in %d, ws %zu < %zu)\n", n_in, ws_size, (size_t)WS_END); grid = -1; return; }
        int dev = 0, cus = 0, per_cu = 0;
        hipGetDevice(&dev);
        hipDeviceGetAttribute(&cus, hipDeviceAttributeMultiprocessorCount, dev);
        hipFuncSetAttribute((const void*)mega, hipFuncAttributeMaxDynamicSharedMemorySize, LDS_BYTES);
        hipOccupancyMaxActiveBlocksPerMultiprocessor(&per_cu, (const void*)mega, NTHREADS, LDS_BYTES);
        if (per_cu < 1) per_cu = 1;
        grid = cus * per_cu;
        (void)hipGetLastError();
    }
    if (grid < 0) return;
    if (hipMemsetAsync((char*)d_ws + WS_CTR, 0, WS_END - WS_CTR, stream) != hipSuccess) { fprintf(stderr, "memset failed\n"); return; }
    if (hipMemsetAsync((char*)d_ws + WS_MOD, 0, 2ull * 5 * 12288 * 4, stream) != hipSuccess) { fprintf(stderr, "memset failed\n"); return; }
    Params p{};
    for (int i = 0; i < 28; ++i) p.in[i] = (const float*)d_in[i];
    p.out = (float*)d_out; p.ws = (unsigned char*)d_ws;
    void* args[] = {&p};
    hipError_t e = hipLaunchCooperativeKernel((const void*)mega, dim3(grid), dim3(NTHREADS), args, LDS_BYTES, stream);
    if (e != hipSuccess) fprintf(stderr, "cooperative launch failed: %s (grid %d)\n", hipGetErrorString(e), grid);
}
```
